# Optimizing an MI355X kernel written in HIP

```python
import jax, jax.numpy as jnp
from jax import lax
import numpy as np

D_MODEL = 1024
BATCH = 32
SEQ = 2048
DEPTH = 2

D_MIX = D_MODEL
D_RNN = D_MIX // 2
D_RET = D_MIX - D_RNN
N_RNN_BLOCKS = 8
RNN_BLOCK = D_RNN // N_RNN_BLOCKS
CONV_WIDTH = 4
LRU_C = 8.0
N_RET_HEADS = 4
RET_HEAD_DIM = D_RET // N_RET_HEADS
CHUNK = 128
ROPE_BASE = 10000.0
D_FF = 2816
EPS = 1e-6
IN_SPLITS = [D_RNN, D_RNN, D_RET, D_RET, D_RET, D_RET]
D_IN = sum(IN_SPLITS)

kernel_name = 'hymba_rglru_retention_macaron'


def rmsnorm(x, g):
    xf = x.astype(jnp.float32)
    y = xf * lax.rsqrt(jnp.mean(xf * xf, axis=-1, keepdims=True) + EPS)
    return (y * g.astype(jnp.float32)).astype(x.dtype)


def head_rmsnorm(y):
    yf = y.astype(jnp.float32)
    return yf * lax.rsqrt(jnp.mean(yf * yf, axis=-1, keepdims=True) + EPS)


def swiglu(x, w_in, w_out):
    gate, up = jnp.split(x @ w_in, 2, axis=-1)
    return (jax.nn.silu(gate) * up) @ w_out


def causal_dwconv(x, w, b):
    seq = x.shape[1]
    k_taps = w.shape[0]
    xp = jnp.pad(x, ((0, 0), (k_taps - 1, 0), (0, 0)))
    y = xp[:, 0:seq] * w[0]
    for k in range(1, k_taps):
        y = y + xp[:, k:k + seq] * w[k]
    return y + b


def rg_lru(x, gate_a_w, gate_a_b, gate_x_w, gate_x_b, lam):
    bsz, seq, ch = x.shape
    xh = x.reshape(bsz, seq, N_RNN_BLOCKS, RNN_BLOCK)
    r_gate = jax.nn.sigmoid(jnp.einsum('bshi,hij->bshj', xh, gate_a_w).reshape(bsz, seq, ch) + gate_a_b).astype(jnp.float32)
    i_gate = jax.nn.sigmoid(jnp.einsum('bshi,hij->bshj', xh, gate_x_w).reshape(bsz, seq, ch) + gate_x_b).astype(jnp.float32)
    log_a = -LRU_C * r_gate * jax.nn.softplus(-lam.astype(jnp.float32))
    a = jnp.exp(log_a)
    u = jnp.sqrt(-jnp.expm1(2.0 * log_a)) * (i_gate * x.astype(jnp.float32))

    def combine(left, right):
        a1, b1 = left
        a2, b2 = right
        return a1 * a2, a2 * b1 + b2

    _, h = lax.associative_scan(combine, (a, u), axis=1)
    return h.astype(x.dtype)


def rotary(t, positions):
    half = t.shape[-1] // 2
    inv_freq = ROPE_BASE ** (-jnp.arange(half, dtype=jnp.float32) / half)
    ang = positions.astype(jnp.float32)[..., None] * inv_freq
    cos = jnp.cos(ang)[:, :, None, :]
    sin = jnp.sin(ang)[:, :, None, :]
    t1 = t[..., :half].astype(jnp.float32)
    t2 = t[..., half:].astype(jnp.float32)
    return jnp.concatenate([t1 * cos - t2 * sin, t1 * sin + t2 * cos], axis=-1).astype(t.dtype)


def chunkwise_retention(q, k, v, positions):
    bsz, seq, n_heads, dh = q.shape
    n_chunks = seq // CHUNK
    q = rotary(q, positions)
    k = rotary(k, positions) * (dh ** -0.5)
    log_gamma = jnp.log1p(-(2.0 ** (-5.0 - jnp.arange(n_heads, dtype=jnp.float32))))
    idx = jnp.arange(CHUNK, dtype=jnp.float32)
    rel = idx[:, None] - idx[None, :]
    decay = jnp.where(rel >= 0, jnp.exp(jnp.maximum(rel, 0.0)[None] * log_gamma[:, None, None]), 0.0)
    xi = jnp.exp((idx + 1.0)[None, :] * log_gamma[:, None])
    zeta = jnp.exp((CHUNK - 1.0 - idx)[None, :] * log_gamma[:, None])
    chunk_decay = jnp.exp(CHUNK * log_gamma)

    qc = q.reshape(bsz, n_chunks, CHUNK, n_heads, dh)
    kc = k.reshape(bsz, n_chunks, CHUNK, n_heads, dh)
    vc = v.reshape(bsz, n_chunks, CHUNK, n_heads, dh)

    scores = jnp.einsum('bnchd,bnmhd->bnhcm', qc, kc) * decay
    inner = jnp.einsum('bnhcm,bnmhe->bnche', scores, vc)
    kv = jnp.einsum('bnmhd,bnmhe,hm->nbhde', kc, vc, zeta)

    def step(state, kv_i):
        return chunk_decay[None, :, None, None] * state + kv_i, state

    _, prev = lax.scan(step, jnp.zeros(kv.shape[1:], kv.dtype), kv)
    cross = jnp.einsum('bnchd,nbhde->bnche', qc, prev) * xi.T[None, None, :, :, None]
    return (inner + cross).reshape(bsz, seq, n_heads, dh)


def setup_inputs(seed: int = 0) -> dict:
    key = jax.random.key(seed)
    ks = jax.random.split(key, 24)
    f32 = jnp.float32
    L = DEPTH

    def nrm(k, shape, scale):
        return jax.random.normal(k, shape, f32) * scale

    u = jax.random.uniform(ks[12], (L, D_RNN), f32, minval=0.9, maxval=0.999)
    a_base = u ** (1.0 / LRU_C)
    lru_lambda = jnp.log(a_base) - jnp.log1p(-a_base)
    offsets = jax.random.randint(ks[20], (BATCH, 1), 0, 4096, dtype=jnp.int32)
    positions = offsets + jnp.arange(SEQ, dtype=jnp.int32)[None, :]
    return {
        'x': nrm(ks[0], (BATCH, SEQ, D_MODEL), 1.0),
        'positions': positions,
        'norm_ffn1': 1.0 + nrm(ks[1], (L, D_MODEL), 0.02),
        'w_ffn1_in': nrm(ks[2], (L, D_MODEL, 2 * D_FF), D_MODEL ** -0.5),
        'w_ffn1_out': nrm(ks[3], (L, D_FF, D_MODEL), D_FF ** -0.5),
        'norm_mix': 1.0 + nrm(ks[4], (L, D_MODEL), 0.02),
        'w_in': nrm(ks[5], (L, D_MODEL, D_IN), D_MODEL ** -0.5),
        'conv_w': nrm(ks[6], (L, CONV_WIDTH, D_RNN), CONV_WIDTH ** -0.5),
        'conv_b': nrm(ks[7], (L, D_RNN), 0.01),
        'gate_a_w': nrm(ks[8], (L, N_RNN_BLOCKS, RNN_BLOCK, RNN_BLOCK), RNN_BLOCK ** -0.5),
        'gate_a_b': nrm(ks[9], (L, D_RNN), 0.01),
        'gate_x_w': nrm(ks[10], (L, N_RNN_BLOCKS, RNN_BLOCK, RNN_BLOCK), RNN_BLOCK ** -0.5),
        'gate_x_b': nrm(ks[11], (L, D_RNN), 0.01),
        'lru_lambda': lru_lambda,
        'w_out': nrm(ks[13], (L, D_MIX, D_MODEL), D_MIX ** -0.5),
        'norm_ffn2': 1.0 + nrm(ks[14], (L, D_MODEL), 0.02),
        'w_ffn2_in': nrm(ks[15], (L, D_MODEL, 2 * D_FF), D_MODEL ** -0.5),
        'w_ffn2_out': nrm(ks[16], (L, D_FF, D_MODEL), D_FF ** -0.5),
        'norm_final': 1.0 + nrm(ks[17], (D_MODEL,), 0.02),
    }


def reference(x, positions, norm_ffn1, w_ffn1_in, w_ffn1_out, norm_mix, w_in, conv_w, conv_b,
              gate_a_w, gate_a_b, gate_x_w, gate_x_b, lru_lambda, w_out, norm_ffn2,
              w_ffn2_in, w_ffn2_out, norm_final):
    bsz, seq, _ = x.shape
    split_idx = [int(s) for s in np.cumsum(IN_SPLITS)[:-1]]
    for l in range(DEPTH):
        x = x + 0.5 * swiglu(rmsnorm(x, norm_ffn1[l]), w_ffn1_in[l], w_ffn1_out[l])

        h = rmsnorm(x, norm_mix[l])
        proj = h @ w_in[l]
        rnn_x, rnn_gate, q, k, v, g = jnp.split(proj, split_idx, axis=-1)

        rnn_x = causal_dwconv(rnn_x, conv_w[l], conv_b[l])
        rnn_y = rg_lru(rnn_x, gate_a_w[l], gate_a_b[l], gate_x_w[l], gate_x_b[l], lru_lambda[l])
        rnn_y = rnn_y * jax.nn.gelu(rnn_gate)

        heads = (bsz, seq, N_RET_HEADS, RET_HEAD_DIM)
        ret = chunkwise_retention(q.reshape(heads), k.reshape(heads), v.reshape(heads), positions)
        ret_y = head_rmsnorm(ret).reshape(bsz, seq, D_RET).astype(x.dtype) * jax.nn.silu(g)

        x = x + jnp.concatenate([rnn_y, ret_y], axis=-1) @ w_out[l]

        x = x + 0.5 * swiglu(rmsnorm(x, norm_ffn2[l]), w_ffn2_in[l], w_ffn2_out[l])
    return rmsnorm(x, norm_final)
```

```cpp
#include <hip/hip_runtime.h>
#include <cstdio>
#include <cstdint>

#ifndef MK_PER_PHASE
#define MK_PER_PHASE 0
#endif

namespace pg8 {
#define PG8_LAS __attribute__((address_space(3)))
typedef unsigned short bf16_t;
typedef short bf16x8 __attribute__((ext_vector_type(8)));
typedef float f32x4 __attribute__((ext_vector_type(4)));
typedef unsigned u32x4 __attribute__((ext_vector_type(4)));
constexpr int BM = 256, BK = 64, HALF = 128, HTB = HALF * BK * 2, STAGE_BYTES = 8 * HTB, NXCD = 8, WGM = 8;

__host__ __device__ __forceinline__ int lds_byte(int r, int c) { const int st = (r >> 4) * 2 + (c >> 5), rr = r & 15, cc = c & 31, ob = rr * 64 + cc * 2; return st * 1024 + (ob ^ (((ob >> 9) & 1) << 5)); }
__host__ __device__ __forceinline__ void stage_rc(int b, int& R, int& C) { const int st = b / 1024, sb = b % 1024, swz = sb ^ (((sb >> 9) & 1) << 5); R = (st >> 1) * 16 + swz / 64; C = (st & 1) * 32 + (swz % 64) / 2; }
__host__ __device__ __forceinline__ int perm32(int rho) { const int n = rho >> 4, i = rho & 15; return 8 * (i >> 2) + 4 * n + (i & 3); }

struct Unit { int pm, pn; };
struct Gemm { const bf16_t* A; const bf16_t* Bt; int M, N, K; };

struct StaticOrder {
    int nM, nN, nwg, G, c;
    __host__ __device__ void init(int M, int N, int G_, int c_) { nM = M / BM; nN = N / BM; nwg = nM * nN; G = G_; c = c_; }
    __host__ __device__ bool next(int i, Unit& u) const {
        const long L = (long)i * G + c; if (L >= nwg) return false;
        int wgid = (int)L; { const int q = nwg / NXCD, r = nwg % NXCD, xcd = wgid % NXCD, off = wgid / NXCD; wgid = (xcd < r ? xcd * (q + 1) : r * (q + 1) + (xcd - r) * q) + off; }
        const int nig = WGM * nN, gid = wgid / nig, fm = gid * WGM, gsz = (nM - fm) < WGM ? (nM - fm) : WGM;
        u.pm = fm + ((wgid % nig) % gsz); u.pn = (wgid % nig) / gsz; return true;
    }
    __device__ __forceinline__ void a_ready(const Unit&) const {}
    __device__ __forceinline__ void done(const Unit&) const {}
};

__device__ __forceinline__ unsigned cvt_pk_bf16(float lo, float hi) { unsigned r; asm volatile("v_cvt_pk_bf16_f32 %0, %1, %2" : "=v"(r) : "v"(lo), "v"(hi)); return r; }

template <class Epi, class Sched, bool ALIGN_EPI = false, bool SP2 = false>
__device__ __forceinline__ void gemm_phase(PG8_LAS unsigned char* lds, const Gemm g, const Sched& S, const Epi& E) {
    int tid = threadIdx.x; asm volatile("" : "+v"(tid));
    const int wid = __builtin_amdgcn_readfirstlane(tid >> 6), lane = tid & 63, wr = wid >> 2, wc = wid & 3, fr = lane & 15, fq = lane >> 4;
    const int K = g.K, nt = K / BK;
    unsigned voffA[2], voffB[2];
#pragma unroll
    for (int i = 0; i < 2; ++i) { int R, C; stage_rc(tid * 16 + i * 8192, R, C); const int Rb = Epi::PERM ? ((R & ~31) + perm32(R & 31)) : R;
        voffA[i] = (unsigned)(R * K + C) * 2u; voffB[i] = (unsigned)(Rb * K + C) * 2u; }
    const size_t kstep = (size_t)(BK * 2);
    const size_t hstep = (size_t)HALF * K * 2;
    const size_t tstep = 2 * hstep;
    const unsigned ldsw = (unsigned)wid * 1024u;
    const int aoff = lds_byte(wr * 64 + fr, fq * 8), boff = lds_byte(wc * 32 + fr, fq * 8);
#define PG8_SA(b, h) (((b) * 2 + (h)) * HTB)
#define PG8_SB(b, h) ((4 + (b) * 2 + (h)) * HTB)
#define PG8_STAGE(bufoff, gbase, voff) do { _Pragma("unroll") for (int _i = 0; _i < 2; ++_i) \
        __builtin_amdgcn_global_load_lds((const unsigned*)((const char*)(gbase) + (voff)[_i]), (PG8_LAS unsigned*)(lds + (bufoff) + ldsw + _i * 8192), 16, 0, 0); } while (0)
#define PG8_LDA(dst, b, h) do { _Pragma("unroll") for (int m = 0; m < 4; ++m) _Pragma("unroll") for (int k = 0; k < 2; ++k) dst[m][k] = *(const PG8_LAS bf16x8*)(lds + PG8_SA(b, h) + aoff + m * 2048 + k * 1024); } while (0)
#define PG8_LDB(dst, b, h) do { _Pragma("unroll") for (int n = 0; n < 2; ++n) _Pragma("unroll") for (int k = 0; k < 2; ++k) dst[n][k] = *(const PG8_LAS bf16x8*)(lds + PG8_SB(b, h) + boff + n * 2048 + k * 1024); } while (0)
#define PG8_MMA(ai, bj, At, Bt) do { __builtin_amdgcn_s_setprio(1); _Pragma("unroll") for (int m = 0; m < 4; ++m) _Pragma("unroll") for (int n = 0; n < 2; ++n) _Pragma("unroll") for (int k = 0; k < 2; ++k) \
        acc[ai][bj][m][n] = __builtin_amdgcn_mfma_f32_16x16x32_bf16(Bt[n][k], At[m][k], acc[ai][bj][m][n], 0, 0, 0); __builtin_amdgcn_s_setprio(0); } while (0)
#define PG8_WAIT_V(n) asm volatile("s_waitcnt vmcnt(" #n ")" ::: "memory")
#define PG8_WAIT_L(n) asm volatile("s_waitcnt lgkmcnt(" #n ")" ::: "memory")
#define PG8_BAR __builtin_amdgcn_s_barrier()
#define PG8_SCHED __builtin_amdgcn_sched_barrier(0)
    Unit cur, nxt; int ui = 0;
    if (!S.next(0, cur)) return;
    f32x4 acc[2][2][4][2];
#pragma unroll
    for (int a = 0; a < 2; ++a)
#pragma unroll
        for (int b = 0; b < 2; ++b)
#pragma unroll
            for (int m = 0; m < 4; ++m)
#pragma unroll
                for (int n = 0; n < 2; ++n) acc[a][b][m][n] = (f32x4){0.f, 0.f, 0.f, 0.f};
    bf16x8 At[4][2], B0[2][2], B1[2][2];
    const char* cA = (const char*)g.A + (size_t)cur.pm * tstep; const char* cB = (const char*)g.Bt + (size_t)cur.pn * tstep;
    S.a_ready(cur);
    if constexpr (SP2) {
        PG8_STAGE(PG8_SB(0, 0), cB, voffB); PG8_STAGE(PG8_SB(0, 1), cB + hstep, voffB); PG8_STAGE(PG8_SA(0, 0), cA, voffA); PG8_STAGE(PG8_SA(0, 1), cA + hstep, voffA);
        if (wr == 1) PG8_BAR;
        PG8_WAIT_V(2); PG8_BAR;
        PG8_STAGE(PG8_SB(1, 0), cB + kstep, voffB); PG8_STAGE(PG8_SA(1, 0), cA + kstep, voffA); PG8_STAGE(PG8_SB(1, 1), cB + hstep + kstep, voffB);
        PG8_WAIT_V(6); PG8_BAR;
    } else {
        PG8_STAGE(PG8_SB(0, 0), cB, voffB); PG8_STAGE(PG8_SA(0, 0), cA, voffA); PG8_STAGE(PG8_SB(0, 1), cB + hstep, voffB); PG8_STAGE(PG8_SA(0, 1), cA + hstep, voffA);
        if (wr == 1) PG8_BAR;
        PG8_WAIT_V(4); PG8_BAR;
        PG8_STAGE(PG8_SB(1, 0), cB + kstep, voffB); PG8_STAGE(PG8_SA(1, 0), cA + kstep, voffA); PG8_STAGE(PG8_SB(1, 1), cB + hstep + kstep, voffB);
        PG8_WAIT_V(6); PG8_BAR;
    }
    for (;;) {
        const bool has_next = S.next(ui + 1, nxt);
        const char* nA = has_next ? (const char*)g.A + (size_t)nxt.pm * tstep : cA; const char* nB = has_next ? (const char*)g.Bt + (size_t)nxt.pn * tstep : cB;
        for (int t = 0; t < nt; t += 2) {
            const bool last = (t == nt - 2);
            const char* a1 = cA + (size_t)(t + 1) * kstep;
            const char* a2 = last ? nA : cA + (size_t)(t + 2) * kstep; const char* b2 = last ? nB : cB + (size_t)(t + 2) * kstep;
            const char* a3 = a2 + kstep; const char* b3 = b2 + kstep;
            if (last && has_next) S.a_ready(nxt);
            if constexpr (SP2) {
            PG8_LDB(B0, 0, 0); PG8_LDB(B1, 0, 1); PG8_SCHED; PG8_LDA(At, 0, 0); PG8_STAGE(PG8_SA(1, 1), a1 + hstep, voffA);
            PG8_WAIT_V(8); PG8_WAIT_L(0); PG8_BAR; PG8_MMA(0, 0, At, B0); PG8_MMA(0, 1, At, B1); PG8_BAR; PG8_SCHED;
            PG8_LDA(At, 0, 1); PG8_STAGE(PG8_SB(0, 0), b2, voffB); PG8_STAGE(PG8_SB(0, 1), b2 + hstep, voffB); PG8_STAGE(PG8_SA(0, 0), a2, voffA);
            PG8_WAIT_V(8); PG8_WAIT_L(0); PG8_BAR; PG8_MMA(1, 0, At, B0); PG8_MMA(1, 1, At, B1); PG8_BAR; PG8_SCHED;
            PG8_LDB(B0, 1, 0); PG8_LDB(B1, 1, 1); PG8_SCHED; PG8_LDA(At, 1, 0); PG8_STAGE(PG8_SA(0, 1), a2 + hstep, voffA);
            PG8_WAIT_V(8); PG8_WAIT_L(0); PG8_BAR; PG8_MMA(0, 0, At, B0); PG8_MMA(0, 1, At, B1); PG8_BAR; PG8_SCHED;
            PG8_LDA(At, 1, 1); PG8_STAGE(PG8_SB(1, 0), b3, voffB); PG8_STAGE(PG8_SB(1, 1), b3 + hstep, voffB); PG8_STAGE(PG8_SA(1, 0), a3, voffA);
            PG8_WAIT_V(8); PG8_WAIT_L(0); PG8_BAR; PG8_MMA(1, 0, At, B0); PG8_MMA(1, 1, At, B1); PG8_BAR; PG8_SCHED;
            } else {
            PG8_LDB(B0, 0, 0); PG8_SCHED; PG8_LDA(At, 0, 0); PG8_STAGE(PG8_SA(1, 1), a1 + hstep, voffA);
            PG8_WAIT_L(8); PG8_BAR; PG8_WAIT_L(0); PG8_MMA(0, 0, At, B0); PG8_BAR; PG8_SCHED;
            PG8_LDB(B1, 0, 1); PG8_STAGE(PG8_SB(0, 0), b2, voffB);
            PG8_BAR; PG8_WAIT_L(0); PG8_MMA(0, 1, At, B1); PG8_BAR;
            PG8_LDA(At, 0, 1); PG8_STAGE(PG8_SA(0, 0), a2, voffA);
            PG8_BAR; PG8_WAIT_L(0); PG8_MMA(1, 0, At, B0); PG8_BAR; PG8_SCHED;
            PG8_STAGE(PG8_SB(0, 1), b2 + hstep, voffB);
            PG8_WAIT_V(6); PG8_BAR; PG8_MMA(1, 1, At, B1); PG8_BAR;
            PG8_LDB(B0, 1, 0); PG8_SCHED; PG8_LDA(At, 1, 0); PG8_STAGE(PG8_SA(0, 1), a2 + hstep, voffA);
            PG8_WAIT_L(8); PG8_BAR; PG8_WAIT_L(0); PG8_MMA(0, 0, At, B0); PG8_BAR; PG8_SCHED;
            PG8_LDB(B1, 1, 1); PG8_STAGE(PG8_SB(1, 0), b3, voffB);
            PG8_BAR; PG8_WAIT_L(0); PG8_MMA(0, 1, At, B1); PG8_BAR;
            PG8_LDA(At, 1, 1); PG8_STAGE(PG8_SA(1, 0), a3, voffA);
            PG8_BAR; PG8_WAIT_L(0); PG8_MMA(1, 0, At, B0); PG8_BAR; PG8_SCHED;
            PG8_STAGE(PG8_SB(1, 1), b3 + hstep, voffB);
            PG8_WAIT_V(6); PG8_BAR; PG8_MMA(1, 1, At, B1); PG8_BAR;
            }
        }
        if constexpr (ALIGN_EPI) { if (wr == 0) PG8_BAR; }
        E(acc, cur, wr, wc, fr, fq); S.done(cur);
        if (!has_next) break;
#pragma unroll
        for (int a = 0; a < 2; ++a)
#pragma unroll
            for (int b = 0; b < 2; ++b)
#pragma unroll
                for (int m = 0; m < 4; ++m)
#pragma unroll
                    for (int n = 0; n < 2; ++n) acc[a][b][m][n] = (f32x4){0.f, 0.f, 0.f, 0.f};
        cur = nxt; cA = nA; cB = nB; ++ui;
        if constexpr (ALIGN_EPI) { if (wr == 1) PG8_BAR; }
    }
    PG8_WAIT_V(0);
    if constexpr (!ALIGN_EPI) { if (wr == 0) PG8_BAR; }
    PG8_BAR;
#undef PG8_SA
#undef PG8_SB
#undef PG8_STAGE
#undef PG8_LDA
#undef PG8_LDB
#undef PG8_MMA
#undef PG8_WAIT_V
#undef PG8_WAIT_L
#undef PG8_BAR
#undef PG8_SCHED
}
}

#define PG8_SP2 true
#define PG8_ALIGN true

constexpr int NWAVES = 8;
constexpr int BATCH = 32, SEQ = 2048, DM = 1024, MTOK = BATCH * SEQ, DFF = 2816, NFF = 2 * DFF, DIN = 3072;
constexpr int DRNN = 512, NRB = 8, RB = 64, NHEAD = 4, DH = 128, CHUNK = 128, NCHUNK = SEQ / CHUNK, DEPTH = 2;
constexpr float EPS = 1e-6f;

constexpr size_t MiB = 1u << 20;
constexpr size_t WS_CTL = 0, CTL_ZERO_BYTES = 1 * MiB;
constexpr size_t SZ_WFIN = (size_t)NFF * DM * 2, SZ_WFOUT = (size_t)DM * DFF * 2, SZ_WIN = (size_t)DIN * DM * 2, SZ_WOUT = (size_t)DM * DM * 2;
constexpr size_t OFF_W1IN = 0, OFF_W1OUT = OFF_W1IN + SZ_WFIN, OFF_WIN = OFF_W1OUT + SZ_WFOUT, OFF_WOUT = OFF_WIN + SZ_WIN, OFF_W2IN = OFF_WOUT + SZ_WOUT, OFF_W2OUT = OFF_W2IN + SZ_WFIN;
constexpr size_t SZ_WLAYER = OFF_W2OUT + SZ_WFOUT;
constexpr size_t WS_W = 2 * MiB;
constexpr size_t WS_XB = 96 * MiB;
constexpr size_t WS_SS = 224 * MiB;
constexpr size_t WS_Y = 232 * MiB;
constexpr size_t WS_PH = 360 * MiB;
constexpr size_t WS_END = 744 * MiB;
static_assert(WS_W + 2 * SZ_WLAYER <= WS_XB, "weights fit");
constexpr int CW_BAR = 4096;

constexpr int LDS_BYTES = 147456;
constexpr int MISC_OFF = LDS_BYTES - 64;

#define LAS __attribute__((address_space(3)))
typedef unsigned short bf16;
typedef unsigned v4u __attribute__((ext_vector_type(4)));
typedef unsigned v2u __attribute__((ext_vector_type(2)));
typedef float f32x4 __attribute__((ext_vector_type(4)));
typedef short bf16x8 __attribute__((ext_vector_type(8)));
typedef short bf16x4 __attribute__((ext_vector_type(4)));
#define LDS_WAIT() asm volatile("s_waitcnt lgkmcnt(0)" ::: "memory")
#define VM_WAIT() asm volatile("s_waitcnt vmcnt(0)" ::: "memory")
__device__ __forceinline__ unsigned f2bf(float f) { unsigned u = __builtin_bit_cast(unsigned, f); return (u + 0x7fffu + ((u >> 16) & 1u)) >> 16; }
__device__ __forceinline__ unsigned pk2(float lo, float hi) { return f2bf(lo) | (f2bf(hi) << 16); }
__device__ __forceinline__ float bf2f(unsigned b) { return __builtin_bit_cast(float, b << 16); }
__device__ __forceinline__ float bflo(unsigned w) { return __builtin_bit_cast(float, w << 16); }
__device__ __forceinline__ float bfhi(unsigned w) { return __builtin_bit_cast(float, w & 0xffff0000u); }

#define XB_TMO      128
#define XB_XCNT(j)  (256  + 64 * (j))
#define XB_XSUB(j)  (1280 + 64 * (j))
#define XB_XGEN(j)  (2304 + 64 * (j))
#define XB_TOP      3328
#define XB_TOPGEN   3392
#define XCD_BAR_WORDS 3456
#define XB_SPIN_CAP (1u << 18)

__device__ __forceinline__ unsigned xb_ld(unsigned* p)              { return __hip_atomic_load(p, __ATOMIC_RELAXED, __HIP_MEMORY_SCOPE_AGENT); }
__device__ __forceinline__ unsigned xb_add(unsigned* p, unsigned v) { return __hip_atomic_fetch_add(p, v, __ATOMIC_RELAXED, __HIP_MEMORY_SCOPE_AGENT); }
__device__ __forceinline__ unsigned xb_xcc_id() { return (unsigned)__builtin_amdgcn_s_getreg((3 << 11) | 20) & 0xFu; }
#define XB_SPIN(cond, bar) do { unsigned _sp = 0; while (cond) { __builtin_amdgcn_s_sleep(1); \
    if ((++_sp & 255u) == 0u) { if (xb_ld(&(bar)[XB_TMO])) break; if (_sp > XB_SPIN_CAP) { atomicAdd(&(bar)[XB_TMO], 1u); break; } } } } while (0)

struct XcdBarrier {
    unsigned* bar; unsigned x;
    volatile LAS unsigned* st;
};
__device__ __forceinline__ XcdBarrier xcd_barrier_post(unsigned* bar, volatile LAS unsigned* st) {
    XcdBarrier b; b.bar = bar; b.x = xb_xcc_id(); b.st = st;
    if (threadIdx.x == 0) (void)xb_add(&bar[XB_XCNT(b.x)], 1u);
    return b;
}
__device__ __forceinline__ void xcd_barrier_complete(unsigned* bar, unsigned x, unsigned& nloc, unsigned& nx) {
    const unsigned G = gridDim.x * gridDim.y * gridDim.z;
    unsigned sum, cnt, mine, sp = 0u;
    for (;;) {
        sum = 0u; cnt = 0u; mine = 0u;
#pragma unroll
        for (unsigned j = 0; j < 16; ++j) { const unsigned c = xb_ld(&bar[XB_XCNT(j)]); sum += c; cnt += (c > 0u) ? 1u : 0u; mine = (j == x) ? c : mine; }
        if (sum == G) break;
        __builtin_amdgcn_s_sleep(1);
        if ((++sp & 255u) == 0u) { if (xb_ld(&bar[XB_TMO])) break; if (sp > XB_SPIN_CAP) { atomicAdd(&bar[XB_TMO], 1u); break; } }
    }
    nloc = mine > 0u ? mine : 1u; nx = cnt > 0u ? cnt : 1u;
}
__device__ __forceinline__ void xcd_barrier(const XcdBarrier& b) {
    asm volatile("s_waitcnt vmcnt(0)" ::: "memory");
    __syncthreads();
    if (threadIdx.x == 0) {
        unsigned* bar = b.bar; asm volatile("" : "+s"(bar));
        __builtin_amdgcn_s_waitcnt(0);
        unsigned nloc = b.st[0], nx = b.st[1];
        if (nloc == 0u) { xcd_barrier_complete(bar, b.x, nloc, nx); b.st[0] = nloc; b.st[1] = nx; }
        const unsigned old = xb_add(&bar[XB_XSUB(b.x)], 1u);
        const unsigned gen = old / nloc;
        if (old + 1u == (gen + 1u) * nloc) {
            __builtin_amdgcn_fence(__ATOMIC_RELEASE, "agent");
            asm volatile("s_waitcnt vmcnt(0)" ::: "memory");
            const unsigned og = xb_add(&bar[XB_TOP], 1u);
            const unsigned tg = og / nx;
            if (og + 1u == (tg + 1u) * nx) xb_add(&bar[XB_TOPGEN], 1u);
            else XB_SPIN(xb_ld(&bar[XB_TOPGEN]) == tg, bar);
            __builtin_amdgcn_fence(__ATOMIC_ACQUIRE, "agent");
            xb_add(&bar[XB_XGEN(b.x)], 1u);
            asm volatile("s_waitcnt vmcnt(0)" ::: "memory");
        } else {
            XB_SPIN(xb_ld(&bar[XB_XGEN(b.x)]) == gen, bar);
            __builtin_amdgcn_fence(__ATOMIC_ACQUIRE, "agent");
            asm volatile("s_waitcnt vmcnt(0)" ::: "memory");
        }
    }
    __syncthreads();
}

__device__ __forceinline__ float row_scale(const float* ss, int row) {
    const f32x4* p = (const f32x4*)(ss + (size_t)row * 16);
    const f32x4 a = p[0], b = p[1], c = p[2], d = p[3];
    const float s = ((a[0] + a[1]) + (a[2] + a[3])) + ((b[0] + b[1]) + (b[2] + b[3])) + ((c[0] + c[1]) + (c[2] + c[3])) + ((d[0] + d[1]) + (d[2] + d[3]));
    return rsqrtf(s * (1.0f / DM) + EPS);
}
__device__ __forceinline__ float sigmoid_f(float v) { return __builtin_amdgcn_rcpf(1.0f + __builtin_amdgcn_exp2f(-1.44269504f * v)); }
__device__ __forceinline__ float silu_f(float v) { return v * sigmoid_f(v); }
__device__ __forceinline__ float gelu_tanh_f(float v) { const float z = 1.5957691216f * (v + 0.044715f * v * v * v); return v * sigmoid_f(z); }

struct EpiSwiGLU {
    static constexpr bool PERM = true, AFTER_DRAIN = false;
    pg8::bf16_t* H; const float* ss;
    __device__ __forceinline__ void operator()(const pg8::f32x4 (&acc)[2][2][4][2], const pg8::Unit& u, int wr, int wc, int fr, int fq) const {
        const int row0 = u.pm * 256 + wr * 64 + fr, col0 = u.pn * 128 + wc * 32 + 8 * fq;
#pragma unroll
        for (int ai = 0; ai < 2; ++ai)
#pragma unroll
            for (int m = 0; m < 4; ++m) {
                const int row = row0 + ai * 128 + m * 16; const float rs = row_scale(ss, row);
                float o[8];
#pragma unroll
                for (int n = 0; n < 2; ++n)
#pragma unroll
                    for (int i = 0; i < 4; ++i) { const float g = acc[ai][0][m][n][i] * rs, up = acc[ai][1][m][n][i] * rs; o[n * 4 + i] = silu_f(g) * up; }
                pg8::u32x4 w; w.x = pg8::cvt_pk_bf16(o[0], o[1]); w.y = pg8::cvt_pk_bf16(o[2], o[3]); w.z = pg8::cvt_pk_bf16(o[4], o[5]); w.w = pg8::cvt_pk_bf16(o[6], o[7]);
                *(pg8::u32x4*)(H + (size_t)row * DFF + col0) = w;
            }
    }
};
struct EpiResid {
    static constexpr bool PERM = true, AFTER_DRAIN = false;
    const float* xin; float* xout; pg8::bf16_t* xb; float* ss; float alpha;
    __device__ __forceinline__ void operator()(const pg8::f32x4 (&acc)[2][2][4][2], const pg8::Unit& u, int wr, int wc, int fr, int fq) const {
        const int row0 = u.pm * 256 + wr * 64 + fr, col0 = u.pn * 256 + wc * 32 + 8 * fq;
#pragma unroll
        for (int ai = 0; ai < 2; ++ai)
#pragma unroll
            for (int m = 0; m < 4; ++m) {
                const int row = row0 + ai * 128 + m * 16; float sq = 0.f;
#pragma unroll
                for (int bj = 0; bj < 2; ++bj) {
                    const size_t off = (size_t)row * DM + col0 + bj * 128;
                    const pg8::f32x4 o0 = *(const pg8::f32x4*)(xin + off), o1 = *(const pg8::f32x4*)(xin + off + 4);
                    const pg8::f32x4 v0 = o0 + acc[ai][bj][m][0] * alpha, v1 = o1 + acc[ai][bj][m][1] * alpha;
                    *(pg8::f32x4*)(xout + off) = v0; *(pg8::f32x4*)(xout + off + 4) = v1;
                    pg8::u32x4 w; w.x = pg8::cvt_pk_bf16(v0[0], v0[1]); w.y = pg8::cvt_pk_bf16(v0[2], v0[3]); w.z = pg8::cvt_pk_bf16(v1[0], v1[1]); w.w = pg8::cvt_pk_bf16(v1[2], v1[3]);
                    *(pg8::u32x4*)(xb + off) = w;
                    sq += (v0[0] * v0[0] + v0[1] * v0[1]) + (v0[2] * v0[2] + v0[3] * v0[3]) + (v1[0] * v1[0] + v1[1] * v1[1]) + (v1[2] * v1[2] + v1[3] * v1[3]);
                }
                sq += __shfl_xor(sq, 16); sq += __shfl_xor(sq, 32);
                if (fq == 0) ss[(size_t)row * 16 + 4 * u.pn + wc] = sq;
            }
    }
};
struct EpiProj {
    static constexpr bool PERM = true, AFTER_DRAIN = false;
    pg8::bf16_t* P; const float* ss; const int* pos;
    __device__ __forceinline__ void operator()(const pg8::f32x4 (&acc)[2][2][4][2], const pg8::Unit& u, int wr, int wc, int fr, int fq) const {
        const int row0 = u.pm * 256 + wr * 64 + fr; const int pn = u.pn;
        if (pn >= 4 && pn < 8) {
            const int jj0 = 32 * (wc & 1) + 8 * fq; const float ksc = (pn >= 6) ? 0.08838834764831845f : 1.0f;
            const size_t cbase = (size_t)256 * pn + 128 * (wc >> 1) + jj0;
#pragma unroll
            for (int ai = 0; ai < 2; ++ai)
#pragma unroll
                for (int m = 0; m < 4; ++m) {
                    const int row = row0 + ai * 128 + m * 16; const float rs = row_scale(ss, row) * ksc; const float p = (float)pos[row];
                    float o1[8], o2[8];
#pragma unroll
                    for (int n = 0; n < 2; ++n)
#pragma unroll
                        for (int i = 0; i < 4; ++i) {
                            const float inv = __builtin_amdgcn_exp2f(-(float)(jj0 + n * 4 + i) * 0.20762050593046014f) * 0.15915494309189535f;
                            float rev = p * inv; rev = rev - floorf(rev);
                            const float sn = __builtin_amdgcn_sinf(rev), cs = __builtin_amdgcn_cosf(rev);
                            const float t1 = acc[ai][0][m][n][i] * rs, t2 = acc[ai][1][m][n][i] * rs;
                            o1[n * 4 + i] = t1 * cs - t2 * sn; o2[n * 4 + i] = t1 * sn + t2 * cs;
                        }
                    pg8::u32x4 w1, w2;
                    w1.x = pg8::cvt_pk_bf16(o1[0], o1[1]); w1.y = pg8::cvt_pk_bf16(o1[2], o1[3]); w1.z = pg8::cvt_pk_bf16(o1[4], o1[5]); w1.w = pg8::cvt_pk_bf16(o1[6], o1[7]);
                    w2.x = pg8::cvt_pk_bf16(o2[0], o2[1]); w2.y = pg8::cvt_pk_bf16(o2[2], o2[3]); w2.z = pg8::cvt_pk_bf16(o2[4], o2[5]); w2.w = pg8::cvt_pk_bf16(o2[6], o2[7]);
                    *(pg8::u32x4*)(P + (size_t)row * DIN + cbase) = w1; *(pg8::u32x4*)(P + (size_t)row * DIN + cbase + 64) = w2;
                }
        } else {
            const int act = (pn == 2 || pn == 3) ? 1 : (pn >= 10 ? 2 : 0);
            const int col0 = pn * 256 + wc * 32 + 8 * fq;
#pragma unroll
            for (int ai = 0; ai < 2; ++ai)
#pragma unroll
                for (int m = 0; m < 4; ++m) {
                    const int row = row0 + ai * 128 + m * 16; const float rs = row_scale(ss, row);
#pragma unroll
                    for (int bj = 0; bj < 2; ++bj) {
                        float o[8];
#pragma unroll
                        for (int n = 0; n < 2; ++n)
#pragma unroll
                            for (int i = 0; i < 4; ++i) { const float v = acc[ai][bj][m][n][i] * rs; o[n * 4 + i] = act == 1 ? gelu_tanh_f(v) : (act == 2 ? silu_f(v) : v); }
                        pg8::u32x4 w; w.x = pg8::cvt_pk_bf16(o[0], o[1]); w.y = pg8::cvt_pk_bf16(o[2], o[3]); w.z = pg8::cvt_pk_bf16(o[4], o[5]); w.w = pg8::cvt_pk_bf16(o[6], o[7]);
                        *(pg8::u32x4*)(P + (size_t)row * DIN + col0 + bj * 128) = w;
                    }
                }
        }
    }
};

struct Args { const void* in[19]; float* out; unsigned char* ws; int ph_lo, ph_hi; };
struct Frame {
    LAS unsigned char* lds;
    int tid, lane, wave, G;
};
__device__ __forceinline__ float wave_sum(float v) {
#pragma unroll
    for (int o = 1; o < 64; o <<= 1) v += __shfl_xor(v, o);
    return v;
}

__device__ __forceinline__ void transpose_item(const float* W, int K, int Nsrc, const float* gain, bf16* WT, int k0, int ndst0, int nsrc0, LAS float* scr, int lane) {
#pragma unroll 8
    for (int i = 0; i < 32; ++i) { const int kk = 2 * i + (lane >> 5); const float gk = gain ? gain[k0 + kk] : 1.0f; scr[kk * 33 + (lane & 31)] = W[(size_t)(k0 + kk) * Nsrc + nsrc0 + (lane & 31)] * gk; }
    LDS_WAIT(); asm volatile("" ::: "memory");
    const int c = lane & 7;
#pragma unroll
    for (int j = 0; j < 4; ++j) { const int n = (lane >> 3) + 8 * j; const LAS float* s = scr + (8 * c) * 33 + n;
        v4u o; o.x = pk2(s[0 * 33], s[1 * 33]); o.y = pk2(s[2 * 33], s[3 * 33]); o.z = pk2(s[4 * 33], s[5 * 33]); o.w = pk2(s[6 * 33], s[7 * 33]);
        *(v4u*)(WT + (size_t)(ndst0 + n) * K + k0 + 8 * c) = o; }
    LDS_WAIT(); asm volatile("" ::: "memory");
}
__device__ __forceinline__ int map_ffn(int n) { const int pn = n >> 8, bj = (n >> 7) & 1, c = n & 127; return bj * DFF + 128 * pn + c; }
__device__ __forceinline__ int map_proj(int n) { const int pn = n >> 8; if (pn < 4 || pn >= 8) return n; const int bj = (n >> 7) & 1, cc = n & 127; return 256 * pn + 128 * (cc >> 6) + 64 * bj + (cc & 63); }

__device__ __forceinline__ void phase_prep(const Frame& F, const Args& a) {
    LAS float* scr = (LAS float*)(F.lds + F.wave * 16384);
    const int gw = blockIdx.x * NWAVES + F.wave, NGW = F.G * NWAVES;
    constexpr int I_FIN = (DM / 64) * (NFF / 32), I_FOUT = (DFF / 64) * (DM / 32), I_IN = (DM / 64) * (DIN / 32), I_OUT = (DM / 64) * (DM / 32);
    constexpr int I_LAYER = 2 * I_FIN + 2 * I_FOUT + I_IN + I_OUT;
    for (int it = gw; it < DEPTH * I_LAYER; it += NGW) {
        const int l = it / I_LAYER; int r = it % I_LAYER;
        unsigned char* wl = a.ws + WS_W + (size_t)l * SZ_WLAYER;
        const float* W; const float* gain; bf16* WT; int K, N, mode;
        if (r < I_FIN) { W = (const float*)a.in[3] + (size_t)l * DM * NFF; gain = (const float*)a.in[2] + l * DM; WT = (bf16*)(wl + OFF_W1IN); K = DM; N = NFF; mode = 1; }
        else if ((r -= I_FIN) < I_FOUT) { W = (const float*)a.in[4] + (size_t)l * DFF * DM; gain = nullptr; WT = (bf16*)(wl + OFF_W1OUT); K = DFF; N = DM; mode = 0; }
        else if ((r -= I_FOUT) < I_IN) { W = (const float*)a.in[6] + (size_t)l * DM * DIN; gain = (const float*)a.in[5] + l * DM; WT = (bf16*)(wl + OFF_WIN); K = DM; N = DIN; mode = 2; }
        else if ((r -= I_IN) < I_OUT) { W = (const float*)a.in[14] + (size_t)l * DM * DM; gain = nullptr; WT = (bf16*)(wl + OFF_WOUT); K = DM; N = DM; mode = 0; }
        else if ((r -= I_OUT) < I_FIN) { W = (const float*)a.in[16] + (size_t)l * DM * NFF; gain = (const float*)a.in[15] + l * DM; WT = (bf16*)(wl + OFF_W2IN); K = DM; N = NFF; mode = 1; }
        else { r -= I_FIN; W = (const float*)a.in[17] + (size_t)l * DFF * DM; gain = nullptr; WT = (bf16*)(wl + OFF_W2OUT); K = DFF; N = DM; mode = 0; }
        const int nblk = N / 32, kb = r / nblk, nb = r % nblk, n0 = 32 * nb;
        const int ns0 = mode == 1 ? map_ffn(n0) : (mode == 2 ? map_proj(n0) : n0);
        transpose_item(W, K, N, gain, WT, 64 * kb, n0, ns0, scr, F.lane);
    }
    const float* x = (const float*)a.in[0]; bf16* xb = (bf16*)(a.ws + WS_XB); float* ss = (float*)(a.ws + WS_SS);
    for (int m = gw; m < MTOK; m += NGW) {
        const f32x4* xr = (const f32x4*)(x + (size_t)m * DM) + F.lane; f32x4 v[4]; float s = 0.f;
#pragma unroll
        for (int j = 0; j < 4; ++j) { v[j] = xr[64 * j]; s += (v[j][0] * v[j][0] + v[j][1] * v[j][1]) + (v[j][2] * v[j][2] + v[j][3] * v[j][3]); }
        s = wave_sum(s);
        v2u* o8 = (v2u*)(xb + (size_t)m * DM) + F.lane;
#pragma unroll
        for (int j = 0; j < 4; ++j) { v2u w; w.x = pk2(v[j][0], v[j][1]); w.y = pk2(v[j][2], v[j][3]); o8[64 * j] = w; }
        if (F.lane < 16) ss[(size_t)m * 16 + F.lane] = F.lane == 0 ? s : 0.f;
    }
}
__device__ __forceinline__ void phase_final(const Frame& F, const Args& a) {
    const int gw = blockIdx.x * NWAVES + F.wave, NGW = F.G * NWAVES;
    const f32x4* gp = (const f32x4*)a.in[18] + F.lane; f32x4 gn[4];
#pragma unroll
    for (int j = 0; j < 4; ++j) gn[j] = gp[64 * j];
    for (int m = gw; m < MTOK; m += NGW) {
        f32x4* xr = (f32x4*)(a.out + (size_t)m * DM) + F.lane; f32x4 v[4]; float s = 0.f;
#pragma unroll
        for (int j = 0; j < 4; ++j) { v[j] = xr[64 * j]; s += (v[j][0] * v[j][0] + v[j][1] * v[j][1]) + (v[j][2] * v[j][2] + v[j][3] * v[j][3]); }
        s = wave_sum(s); const float rs = rsqrtf(s * (1.0f / DM) + EPS);
#pragma unroll
        for (int j = 0; j < 4; ++j) xr[64 * j] = v[j] * rs * gn[j];
    }
}

constexpr int L_WA = 0, L_WX = 9216, L_RAW = 18432, L_XCB = 35200, L_XCF = 53632, L_AA = 86400, L_CAR = 119168, L_END = 123264;
static_assert(L_END <= MISC_OFF, "lru lds");
__device__ __forceinline__ void lru_unit(const Frame& F, const Args& a, int layer, int b, int j) {
    LAS unsigned char* lds = F.lds;
    int tid0 = F.tid; asm volatile("" : "+v"(tid0));
    const bf16* P = (const bf16*)(a.ws + WS_PH); bf16* Y = (bf16*)(a.ws + WS_Y);
    const float* gaw = (const float*)a.in[9] + ((size_t)layer * NRB + j) * RB * RB; const float* gxw = (const float*)a.in[11] + ((size_t)layer * NRB + j) * RB * RB;
    const float* gab = (const float*)a.in[10] + layer * DRNN + j * RB; const float* gxb = (const float*)a.in[12] + layer * DRNN + j * RB;
    const float* lam = (const float*)a.in[13] + layer * DRNN + j * RB;
    const float* cw = (const float*)a.in[7] + (size_t)layer * 4 * DRNN + j * RB; const float* cb = (const float*)a.in[8] + layer * DRNN + j * RB;
    __syncthreads();
#pragma unroll
    for (int r = 0; r < 8; ++r) { const int e = tid0 + 512 * r, i = e >> 6, o = e & 63;
        ((LAS bf16*)(lds + L_WA))[o * 72 + i] = (bf16)f2bf(gaw[e]); ((LAS bf16*)(lds + L_WX))[o * 72 + i] = (bf16)f2bf(gxw[e]); }
    const int cc0 = tid0 & 63;
    float cwk[4];
#pragma unroll
    for (int k = 0; k < 4; ++k) cwk[k] = cw[k * DRNN + cc0];
    const float cbias = cb[cc0];
    float ba[4], bx[4], cl[4];
#pragma unroll
    for (int ob = 0; ob < 4; ++ob) { const int o = 16 * ob + (tid0 & 15); ba[ob] = gab[o]; bx[ob] = gxb[o];
        const float nl = -lam[o]; const float sp = (nl > 20.f) ? nl : log1pf(__expf(nl));
        cl[ob] = -8.0f * sp * 1.44269504f; }
    float hcar = 0.f;
    for (int step = 0; step < SEQ / 128; ++step) {
        const int t0 = step * 128;
        int tid = tid0, w = F.wave; asm volatile("" : "+v"(tid)); asm volatile("" : "+s"(w));
        const int lane = tid & 63, col = lane & 15, q = lane >> 4, cc = tid & 63;
        __syncthreads();
#pragma unroll
        for (int r = 0; r < 3; ++r) { const int p = tid + 512 * r; if (p < 131 * 8) { const int row = p >> 3, seg = p & 7, tok = t0 - 3 + row;
            v4u v = (v4u){0u, 0u, 0u, 0u}; if (tok >= 0) v = *(const v4u*)(P + (size_t)(b * SEQ + tok) * DIN + j * RB + 8 * seg);
            *(LAS v4u*)(lds + L_RAW + row * 128 + seg * 16) = v; } }
        __syncthreads();
#pragma unroll
        for (int r = 0; r < 16; ++r) { const int e = tid + 512 * r, t = e >> 6;
            float xc = cbias;
#pragma unroll
            for (int k = 0; k < 4; ++k) xc += cwk[k] * bf2f(((const LAS bf16*)(lds + L_RAW))[(t + k) * 64 + cc]);
            ((LAS float*)(lds + L_XCF))[t * 64 + cc] = xc; ((LAS bf16*)(lds + L_XCB))[t * 72 + cc] = (bf16)f2bf(xc); }
        __syncthreads();
        {
            bf16x8 af[2];
#pragma unroll
            for (int s = 0; s < 2; ++s) af[s] = *(const LAS bf16x8*)(lds + L_XCB + ((16 * w + col) * 72 + 32 * s + 8 * q) * 2);
#pragma unroll
            for (int ob = 0; ob < 4; ++ob) {
                f32x4 za = (f32x4){0.f, 0.f, 0.f, 0.f}, zx = (f32x4){0.f, 0.f, 0.f, 0.f};
#pragma unroll
                for (int s = 0; s < 2; ++s) {
                    const bf16x8 wa = *(const LAS bf16x8*)(lds + L_WA + ((16 * ob + col) * 72 + 32 * s + 8 * q) * 2);
                    const bf16x8 wx = *(const LAS bf16x8*)(lds + L_WX + ((16 * ob + col) * 72 + 32 * s + 8 * q) * 2);
                    za = __builtin_amdgcn_mfma_f32_16x16x32_bf16(af[s], wa, za, 0, 0, 0);
                    zx = __builtin_amdgcn_mfma_f32_16x16x32_bf16(af[s], wx, zx, 0, 0, 0);
                }
#pragma unroll
                for (int r = 0; r < 4; ++r) { const int tok = 16 * w + 4 * q + r, o = 16 * ob + col;
                    const float ra = sigmoid_f(za[r] + ba[ob]), ri = sigmoid_f(zx[r] + bx[ob]);
                    const float av = __builtin_amdgcn_exp2f(cl[ob] * ra);
                    const float xc = ((const LAS float*)(lds + L_XCF))[tok * 64 + o];
                    const float uu = sqrtf(fmaxf(1.0f - av * av, 0.f)) * ri * xc;
                    ((LAS float*)(lds + L_AA))[tok * 64 + o] = av; ((LAS float*)(lds + L_XCF))[tok * 64 + o] = uu; }
            }
        }
        LDS_WAIT();
        {
            float h = 0.f, p = 1.f;
#pragma unroll
            for (int t = 0; t < 16; ++t) { const int idx = (16 * w + t) * 64 + lane;
                const float av = ((const LAS float*)(lds + L_AA))[idx], uu = ((const LAS float*)(lds + L_XCF))[idx];
                h = av * h + uu; p = p * av;
                ((LAS float*)(lds + L_XCF))[idx] = h; ((LAS float*)(lds + L_AA))[idx] = p; }
            ((LAS float*)(lds + L_CAR))[(w * 2 + 0) * 64 + lane] = p; ((LAS float*)(lds + L_CAR))[(w * 2 + 1) * 64 + lane] = h;
        }
        __syncthreads();
        {
            float hin = hcar, hall = hcar;
#pragma unroll
            for (int w2 = 0; w2 < 8; ++w2) { const float pp = ((const LAS float*)(lds + L_CAR))[(w2 * 2 + 0) * 64 + lane], hh = ((const LAS float*)(lds + L_CAR))[(w2 * 2 + 1) * 64 + lane];
                hall = pp * hall + hh; if (w2 < w) hin = pp * hin + hh; }
            hcar = hall;
#pragma unroll
            for (int t = 0; t < 16; ++t) { const int idx = (16 * w + t) * 64 + lane;
                const float h = ((const LAS float*)(lds + L_XCF))[idx] + ((const LAS float*)(lds + L_AA))[idx] * hin;
                const size_t row = (size_t)(b * SEQ + t0 + 16 * w + t);
                const float g = bf2f(P[row * DIN + DRNN + j * RB + lane]);
                Y[row * DM + j * RB + lane] = (bf16)f2bf(h * g); }
        }
    }
}

constexpr int RS = 136;
constexpr int R_KI = 0, R_KT = 34816, R_VT = 69632, R_PT = 104448, R_END = 139264;
static_assert(R_END <= MISC_OFF, "retention lds");
__device__ __forceinline__ void ret_unit(const Frame& F, const Args& a, int b, int hh) {
    LAS unsigned char* lds = F.lds;
    const bf16* P = (const bf16*)(a.ws + WS_PH); bf16* Y = (bf16*)(a.ws + WS_Y);
    const float gamma = 1.0f - __builtin_amdgcn_exp2f(-5.0f - (float)hh); const float lg = __builtin_amdgcn_logf(gamma);
    const float cdecay = __builtin_amdgcn_exp2f(128.0f * lg);
    f32x4 kvacc[8];
#pragma unroll
    for (int d = 0; d < 8; ++d) kvacc[d] = (f32x4){0.f, 0.f, 0.f, 0.f};
    for (int n = 0; n < NCHUNK; ++n) {
        int tid = F.tid, w = F.wave; asm volatile("" : "+v"(tid)); asm volatile("" : "+s"(w));
        const int lane = tid & 63, col = lane & 15, q = lane >> 4;
        const size_t row0 = (size_t)b * SEQ + (size_t)n * CHUNK;
        __syncthreads();
#pragma unroll
        for (int i = 0; i < 4; ++i) { const int piece = tid + 512 * i, m = piece >> 4, d8 = piece & 15;
            const v4u kk = *(const v4u*)(P + (row0 + m) * DIN + 1536 + 128 * hh + 8 * d8);
            const v4u vv = *(const v4u*)(P + (row0 + m) * DIN + 2048 + 128 * hh + 8 * d8);
            *(LAS v4u*)(lds + R_KI + (m * RS + 8 * d8) * 2) = kk;
            const float zeta = __builtin_amdgcn_exp2f((float)(127 - m) * lg);
            const unsigned kw[4] = {kk.x, kk.y, kk.z, kk.w}, vw[4] = {vv.x, vv.y, vv.z, vv.w};
#pragma unroll
            for (int jj = 0; jj < 4; ++jj) {
                ((LAS bf16*)(lds + R_KT))[(8 * d8 + 2 * jj) * RS + m] = (bf16)f2bf(bflo(kw[jj]) * zeta);
                ((LAS bf16*)(lds + R_KT))[(8 * d8 + 2 * jj + 1) * RS + m] = (bf16)f2bf(bfhi(kw[jj]) * zeta);
                ((LAS bf16*)(lds + R_VT))[(8 * d8 + 2 * jj) * RS + m] = (bf16)(vw[jj] & 0xffffu);
                ((LAS bf16*)(lds + R_VT))[(8 * d8 + 2 * jj + 1) * RS + m] = (bf16)(vw[jj] >> 16);
            } }
#pragma unroll
        for (int db = 0; db < 8; ++db) { v2u pw; pw.x = pk2(kvacc[db][0], kvacc[db][1]); pw.y = pk2(kvacc[db][2], kvacc[db][3]);
            *(LAS v2u*)(lds + R_PT + ((16 * w + col) * RS + 16 * db + 4 * q) * 2) = pw; }
        __syncthreads();
        bf16x8 qf[4];
#pragma unroll
        for (int s = 0; s < 4; ++s) qf[s] = *(const bf16x8*)(P + (row0 + 16 * w + col) * DIN + 1024 + 128 * hh + 32 * s + 8 * q);
        f32x4 out[8];
#pragma unroll
        for (int eb = 0; eb < 8; ++eb) { f32x4 c4 = (f32x4){0.f, 0.f, 0.f, 0.f};
#pragma unroll
            for (int s = 0; s < 4; ++s) { const bf16x8 pf = *(const LAS bf16x8*)(lds + R_PT + ((16 * eb + col) * RS + 32 * s + 8 * q) * 2);
                c4 = __builtin_amdgcn_mfma_f32_16x16x32_bf16(pf, qf[s], c4, 0, 0, 0); }
            out[eb] = c4; asm volatile("" ::: "memory"); }
        {
            const float xi = __builtin_amdgcn_exp2f((float)(16 * w + col + 1) * lg);
#pragma unroll
            for (int eb = 0; eb < 8; ++eb) out[eb] = out[eb] * xi;
        }
#pragma unroll
        for (int t = 0; t < 4; ++t) {
            f32x4 sa = (f32x4){0.f, 0.f, 0.f, 0.f}, sb = (f32x4){0.f, 0.f, 0.f, 0.f};
#pragma unroll
            for (int s = 0; s < 4; ++s) {
                const bf16x8 ka = *(const LAS bf16x8*)(lds + R_KI + ((32 * t + col) * RS + 32 * s + 8 * q) * 2);
                const bf16x8 kb = *(const LAS bf16x8*)(lds + R_KI + ((32 * t + 16 + col) * RS + 32 * s + 8 * q) * 2);
                sa = __builtin_amdgcn_mfma_f32_16x16x32_bf16(ka, qf[s], sa, 0, 0, 0);
                sb = __builtin_amdgcn_mfma_f32_16x16x32_bf16(kb, qf[s], sb, 0, 0, 0);
            }
            const int c = 16 * w + col;
            float va[4], vb[4];
#pragma unroll
            for (int r = 0; r < 4; ++r) { const int ma = 32 * t + 4 * q + r, mb = ma + 16;
                va[r] = (c >= ma) ? sa[r] * __builtin_amdgcn_exp2f((float)(c - ma) * lg) : 0.f;
                vb[r] = (c >= mb) ? sb[r] * __builtin_amdgcn_exp2f((float)(c - mb) * lg) : 0.f; }
            v4u sw; sw.x = pk2(va[0], va[1]); sw.y = pk2(va[2], va[3]); sw.z = pk2(vb[0], vb[1]); sw.w = pk2(vb[2], vb[3]);
            const bf16x8 sfr = __builtin_bit_cast(bf16x8, sw);
#pragma unroll
            for (int eb = 0; eb < 8; ++eb) {
                const v2u lo = *(const LAS v2u*)(lds + R_VT + ((16 * eb + col) * RS + 32 * t + 4 * q) * 2);
                const v2u hi = *(const LAS v2u*)(lds + R_VT + ((16 * eb + col) * RS + 32 * t + 16 + 4 * q) * 2);
                const v4u vf = (v4u){lo.x, lo.y, hi.x, hi.y};
                out[eb] = __builtin_amdgcn_mfma_f32_16x16x32_bf16(__builtin_bit_cast(bf16x8, vf), sfr, out[eb], 0, 0, 0);
            }
            asm volatile("" ::: "memory");
        }
        {
            float sq = 0.f;
#pragma unroll
            for (int eb = 0; eb < 8; ++eb) sq += (out[eb][0] * out[eb][0] + out[eb][1] * out[eb][1]) + (out[eb][2] * out[eb][2] + out[eb][3] * out[eb][3]);
            sq += __shfl_xor(sq, 16); sq += __shfl_xor(sq, 32);
            const float rs = rsqrtf(sq * (1.0f / DH) + EPS);
            const size_t row = row0 + 16 * w + col;
#pragma unroll
            for (int eb = 0; eb < 8; ++eb) {
                const v2u gw2 = *(const v2u*)(P + row * DIN + 2560 + 128 * hh + 16 * eb + 4 * q);
                v2u o; o.x = pk2(out[eb][0] * rs * bflo(gw2.x), out[eb][1] * rs * bfhi(gw2.x)); o.y = pk2(out[eb][2] * rs * bflo(gw2.y), out[eb][3] * rs * bfhi(gw2.y));
                *(v2u*)(Y + row * DM + DRNN + 128 * hh + 16 * eb + 4 * q) = o;
            }
        }
        {
            bf16x8 vf[4];
#pragma unroll
            for (int t = 0; t < 4; ++t) vf[t] = *(const LAS bf16x8*)(lds + R_VT + ((16 * w + col) * RS + 32 * t + 8 * q) * 2);
#pragma unroll
            for (int db = 0; db < 8; ++db) { f32x4 c4 = kvacc[db] * cdecay;
#pragma unroll
                for (int t = 0; t < 4; ++t) { const bf16x8 kf = *(const LAS bf16x8*)(lds + R_KT + ((16 * db + col) * RS + 32 * t + 8 * q) * 2);
                    c4 = __builtin_amdgcn_mfma_f32_16x16x32_bf16(kf, vf[t], c4, 0, 0, 0); }
                kvacc[db] = c4; asm volatile("" ::: "memory"); }
        }
    }
}

__global__ void __launch_bounds__(NWAVES * 64, 2) hymba_fwd(Args args) {
    extern __shared__ __attribute__((aligned(16))) unsigned char lds_raw[];
    Frame F;
    F.lds = (LAS unsigned char*)lds_raw;
    F.tid = threadIdx.x; F.lane = F.tid & 63; F.wave = __builtin_amdgcn_readfirstlane(F.tid >> 6); F.G = gridDim.x;
    unsigned char* ws = args.ws;
    const int lo = args.ph_lo, hi = args.ph_hi;
    if (F.tid < 16) ((LAS unsigned*)(F.lds + MISC_OFF))[F.tid] = 0u;
    __syncthreads();
    XcdBarrier bar; bar.bar = (unsigned*)(ws + WS_CTL) + CW_BAR; bar.x = 0; bar.st = nullptr;
    if (hi - lo > 1) bar = xcd_barrier_post((unsigned*)(ws + WS_CTL) + CW_BAR, (volatile LAS unsigned*)(F.lds + MISC_OFF));
#define IN(k) (lo <= (k) && (k) < hi)
#define SEAM(k) do { if (IN(k) && IN((k) + 1)) xcd_barrier(bar); } while (0)

    bf16* XB = (bf16*)(ws + WS_XB); float* SS = (float*)(ws + WS_SS); bf16* YB = (bf16*)(ws + WS_Y); bf16* PH = (bf16*)(ws + WS_PH);

#ifndef SK_PREP
    if (IN(0)) { phase_prep(F, args); }
#endif

    SEAM(0);
    for (int sb = 0; sb < 3 * DEPTH; ++sb) {
        const int l = sb / 3, t = sb % 3; const int p0 = 1 + 7 * l + (t == 0 ? 0 : (t == 1 ? 2 : 5));
        unsigned char* wl = ws + WS_W + (size_t)l * SZ_WLAYER;
        if (t != 1) {
#ifndef SK_FFNIN
            if (IN(p0)) {
                pg8::Gemm g{XB, (const bf16*)(wl + (t == 0 ? OFF_W1IN : OFF_W2IN)), MTOK, NFF, DM}; pg8::StaticOrder S; S.init(MTOK, NFF, F.G, (int)blockIdx.x);
                EpiSwiGLU E{PH, SS};
                pg8::gemm_phase<EpiSwiGLU, pg8::StaticOrder, PG8_ALIGN, PG8_SP2>(F.lds, g, S, E);
            }
#endif

            SEAM(p0);
#ifndef SK_FFNOUT
            if (IN(p0 + 1)) {
                pg8::Gemm g{PH, (const bf16*)(wl + (t == 0 ? OFF_W1OUT : OFF_W2OUT)), MTOK, DM, DFF}; pg8::StaticOrder S; S.init(MTOK, DM, F.G, (int)blockIdx.x);
                EpiResid E{(sb == 0) ? (const float*)args.in[0] : (const float*)args.out, args.out, XB, SS, 0.5f};
                pg8::gemm_phase<EpiResid, pg8::StaticOrder, PG8_ALIGN, PG8_SP2>(F.lds, g, S, E);
            }
#endif

            SEAM(p0 + 1);
        } else {
#ifndef SK_PROJ
            if (IN(p0)) {
                pg8::Gemm g{XB, (const bf16*)(wl + OFF_WIN), MTOK, DIN, DM}; pg8::StaticOrder S; S.init(MTOK, DIN, F.G, (int)blockIdx.x);
                EpiProj E{PH, SS, (const int*)args.in[1]};
                pg8::gemm_phase<EpiProj, pg8::StaticOrder, PG8_ALIGN, PG8_SP2>(F.lds, g, S, E);
            }
#endif

            SEAM(p0);
            if (IN(p0 + 1)) {
#ifndef SK_LRU
                for (int u = blockIdx.x; u < BATCH * NRB; u += F.G) lru_unit(F, args, l, u / NRB, u % NRB);
#endif

#ifndef SK_RET
                for (int u = blockIdx.x; u < BATCH * NHEAD; u += F.G) ret_unit(F, args, u / NHEAD, u % NHEAD);
#endif

            }
            SEAM(p0 + 1);
#ifndef SK_WOUT
            if (IN(p0 + 2)) {
                pg8::Gemm g{YB, (const bf16*)(wl + OFF_WOUT), MTOK, DM, DM}; pg8::StaticOrder S; S.init(MTOK, DM, F.G, (int)blockIdx.x);
                EpiResid E{(const float*)args.out, args.out, XB, SS, 1.0f};
                pg8::gemm_phase<EpiResid, pg8::StaticOrder, PG8_ALIGN, PG8_SP2>(F.lds, g, S, E);
            }
#endif

            SEAM(p0 + 2);
        }
    }
#ifndef SK_FINAL
    if (IN(1 + 7 * DEPTH)) phase_final(F, args);
#endif

#undef IN
#undef SEAM
}

extern "C" void kernel_launch(void* const* d_in, const int* in_sizes, int n_in, void* d_out, int out_size, void* d_ws, size_t ws_size, hipStream_t stream) {
    static int grid = 0;
    if (grid == 0) {
        if (n_in != 19 || in_sizes[0] != MTOK * DM || out_size != MTOK * DM || ws_size < WS_END) {
            fprintf(stderr, "kernel_launch: unexpected shapes (n_in %d, in0 %d, out %d, ws %zu); nothing launched\n", n_in, n_in > 0 ? in_sizes[0] : -1, out_size, ws_size); grid = -1; return; }
        int dev = 0, cus = 0, per_cu = 0;
        if (hipGetDevice(&dev) != hipSuccess || hipDeviceGetAttribute(&cus, hipDeviceAttributeMultiprocessorCount, dev) != hipSuccess) { grid = -1; return; }
        if (hipFuncSetAttribute((const void*)hymba_fwd, hipFuncAttributeMaxDynamicSharedMemorySize, LDS_BYTES) != hipSuccess) { fprintf(stderr, "kernel_launch: hipFuncSetAttribute failed\n"); grid = -1; return; }
        if (hipOccupancyMaxActiveBlocksPerMultiprocessor(&per_cu, (const void*)hymba_fwd, NWAVES * 64, LDS_BYTES) != hipSuccess || per_cu < 1)
            fprintf(stderr, "kernel_launch: note: occupancy query reports %d workgroups per CU\n", per_cu);
        (void)hipGetLastError();
        grid = cus;
    }
    if (grid < 0) return;
    (void)hipMemsetAsync((char*)d_ws + WS_CTL, 0, CTL_ZERO_BYTES, stream);
    Args a{};
    for (int i = 0; i < 19; ++i) a.in[i] = d_in[i];
    a.out = (float*)d_out; a.ws = (unsigned char*)d_ws;
    constexpr int NPH = 2 + 7 * DEPTH;
#if MK_PER_PHASE
    for (int p = 0; p < NPH; ++p) { a.ph_lo = p; a.ph_hi = p + 1; hipLaunchKernelGGL(hymba_fwd, dim3(grid), dim3(NWAVES * 64), LDS_BYTES, stream, a); }
#else
    a.ph_lo = 0; a.ph_hi = NPH; hipLaunchKernelGGL(hymba_fwd, dim3(grid), dim3(NWAVES * 64), LDS_BYTES, stream, a);
#endif
}
```

```cpp
#include <hip/hip_runtime.h>
#include <cstdio>
#include <cstdint>

#define REP_LRU 1
#define REP_RET 1
#define RET_V2 1
#define PROBE_REP_PHASE -1
#ifndef MK_PER_PHASE
#define MK_PER_PHASE 0
#endif

namespace pg8 {
#define PG8_LAS __attribute__((address_space(3)))
typedef unsigned short bf16_t;
typedef short bf16x8 __attribute__((ext_vector_type(8)));
typedef float f32x4 __attribute__((ext_vector_type(4)));
typedef unsigned u32x4 __attribute__((ext_vector_type(4)));
constexpr int BM = 256, BK = 64, HALF = 128, HTB = HALF * BK * 2, STAGE_BYTES = 8 * HTB, NXCD = 8, WGM = 8;

__host__ __device__ __forceinline__ int lds_byte(int r, int c) { const int st = (r >> 4) * 2 + (c >> 5), rr = r & 15, cc = c & 31, ob = rr * 64 + cc * 2; return st * 1024 + (ob ^ (((ob >> 9) & 1) << 5)); }
__host__ __device__ __forceinline__ void stage_rc(int b, int& R, int& C) { const int st = b / 1024, sb = b % 1024, swz = sb ^ (((sb >> 9) & 1) << 5); R = (st >> 1) * 16 + swz / 64; C = (st & 1) * 32 + (swz % 64) / 2; }
__host__ __device__ __forceinline__ int perm32(int rho) { const int n = rho >> 4, i = rho & 15; return 8 * (i >> 2) + 4 * n + (i & 3); }

struct Unit { int pm, pn; };
struct Gemm { const bf16_t* A; const bf16_t* Bt; int M, N, K; };

struct StaticOrder {
    int nM, nN, nwg, G, c;
    __host__ __device__ void init(int M, int N, int G_, int c_) { nM = M / BM; nN = N / BM; nwg = nM * nN; G = G_; c = c_; }
    __host__ __device__ bool next(int i, Unit& u) const {
        const long L = (long)i * G + c; if (L >= nwg) return false;
        int wgid = (int)L; { const int q = nwg / NXCD, r = nwg % NXCD, xcd = wgid % NXCD, off = wgid / NXCD; wgid = (xcd < r ? xcd * (q + 1) : r * (q + 1) + (xcd - r) * q) + off; }
        const int nig = WGM * nN, gid = wgid / nig, fm = gid * WGM, gsz = (nM - fm) < WGM ? (nM - fm) : WGM;
        u.pm = fm + ((wgid % nig) % gsz); u.pn = (wgid % nig) / gsz; return true;
    }
    __device__ __forceinline__ void a_ready(const Unit&) const {}
    __device__ __forceinline__ void done(const Unit&) const {}
};

__device__ __forceinline__ unsigned cvt_pk_bf16(float lo, float hi) { unsigned r; asm volatile("v_cvt_pk_bf16_f32 %0, %1, %2" : "=v"(r) : "v"(lo), "v"(hi)); return r; }

template <class Epi, class Sched, bool ALIGN_EPI = false, bool SP2 = false>
__device__ __forceinline__ void gemm_phase(PG8_LAS unsigned char* lds, const Gemm g, const Sched& S, const Epi& E) {
    int tid = threadIdx.x; asm volatile("" : "+v"(tid));
    const int wid = __builtin_amdgcn_readfirstlane(tid >> 6), lane = tid & 63, wr = wid >> 2, wc = wid & 3, fr = lane & 15, fq = lane >> 4;
    const int K = g.K, nt = K / BK;
    unsigned voffA[2], voffB[2];
#pragma unroll
    for (int i = 0; i < 2; ++i) { int R, C; stage_rc(tid * 16 + i * 8192, R, C); const int Rb = Epi::PERM ? ((R & ~31) + perm32(R & 31)) : R;
        voffA[i] = (unsigned)(R * K + C) * 2u; voffB[i] = (unsigned)(Rb * K + C) * 2u; }
    const size_t kstep = (size_t)(BK * 2);
    const size_t hstep = (size_t)HALF * K * 2;
    const size_t tstep = 2 * hstep;
    const unsigned ldsw = (unsigned)wid * 1024u;
    const int aoff = lds_byte(wr * 64 + fr, fq * 8), boff = lds_byte(wc * 32 + fr, fq * 8);
#define PG8_SA(b, h) (((b) * 2 + (h)) * HTB)
#define PG8_SB(b, h) ((4 + (b) * 2 + (h)) * HTB)
#define PG8_STAGE(bufoff, gbase, voff) do { _Pragma("unroll") for (int _i = 0; _i < 2; ++_i) \
        __builtin_amdgcn_global_load_lds((const unsigned*)((const char*)(gbase) + (voff)[_i]), (PG8_LAS unsigned*)(lds + (bufoff) + ldsw + _i * 8192), 16, 0, 0); } while (0)
#define PG8_LDA(dst, b, h) do { _Pragma("unroll") for (int m = 0; m < 4; ++m) _Pragma("unroll") for (int k = 0; k < 2; ++k) dst[m][k] = *(const PG8_LAS bf16x8*)(lds + PG8_SA(b, h) + aoff + m * 2048 + k * 1024); } while (0)
#define PG8_LDB(dst, b, h) do { _Pragma("unroll") for (int n = 0; n < 2; ++n) _Pragma("unroll") for (int k = 0; k < 2; ++k) dst[n][k] = *(const PG8_LAS bf16x8*)(lds + PG8_SB(b, h) + boff + n * 2048 + k * 1024); } while (0)
#define PG8_MMA(ai, bj, At, Bt) do { __builtin_amdgcn_s_setprio(1); _Pragma("unroll") for (int m = 0; m < 4; ++m) _Pragma("unroll") for (int n = 0; n < 2; ++n) _Pragma("unroll") for (int k = 0; k < 2; ++k) \
        acc[ai][bj][m][n] = __builtin_amdgcn_mfma_f32_16x16x32_bf16(Bt[n][k], At[m][k], acc[ai][bj][m][n], 0, 0, 0); __builtin_amdgcn_s_setprio(0); } while (0)
#define PG8_WAIT_V(n) asm volatile("s_waitcnt vmcnt(" #n ")" ::: "memory")
#define PG8_WAIT_L(n) asm volatile("s_waitcnt lgkmcnt(" #n ")" ::: "memory")
#define PG8_BAR __builtin_amdgcn_s_barrier()
#define PG8_SCHED __builtin_amdgcn_sched_barrier(0)
    Unit cur, nxt; int ui = 0;
    if (!S.next(0, cur)) return;
    f32x4 acc[2][2][4][2];
#pragma unroll
    for (int a = 0; a < 2; ++a)
#pragma unroll
        for (int b = 0; b < 2; ++b)
#pragma unroll
            for (int m = 0; m < 4; ++m)
#pragma unroll
                for (int n = 0; n < 2; ++n) acc[a][b][m][n] = (f32x4){0.f, 0.f, 0.f, 0.f};
    bf16x8 At[4][2], B0[2][2], B1[2][2];
    const char* cA = (const char*)g.A + (size_t)cur.pm * tstep; const char* cB = (const char*)g.Bt + (size_t)cur.pn * tstep;
    S.a_ready(cur);
    if constexpr (SP2) {
        PG8_STAGE(PG8_SB(0, 0), cB, voffB); PG8_STAGE(PG8_SB(0, 1), cB + hstep, voffB); PG8_STAGE(PG8_SA(0, 0), cA, voffA); PG8_STAGE(PG8_SA(0, 1), cA + hstep, voffA);
        if (wr == 1) PG8_BAR;
        PG8_WAIT_V(2); PG8_BAR;
        PG8_STAGE(PG8_SB(1, 0), cB + kstep, voffB); PG8_STAGE(PG8_SA(1, 0), cA + kstep, voffA); PG8_STAGE(PG8_SB(1, 1), cB + hstep + kstep, voffB);
        PG8_WAIT_V(6); PG8_BAR;
    } else {
        PG8_STAGE(PG8_SB(0, 0), cB, voffB); PG8_STAGE(PG8_SA(0, 0), cA, voffA); PG8_STAGE(PG8_SB(0, 1), cB + hstep, voffB); PG8_STAGE(PG8_SA(0, 1), cA + hstep, voffA);
        if (wr == 1) PG8_BAR;
        PG8_WAIT_V(4); PG8_BAR;
        PG8_STAGE(PG8_SB(1, 0), cB + kstep, voffB); PG8_STAGE(PG8_SA(1, 0), cA + kstep, voffA); PG8_STAGE(PG8_SB(1, 1), cB + hstep + kstep, voffB);
        PG8_WAIT_V(6); PG8_BAR;
    }
    for (;;) {
        const bool has_next = S.next(ui + 1, nxt);
        const char* nA = has_next ? (const char*)g.A + (size_t)nxt.pm * tstep : cA; const char* nB = has_next ? (const char*)g.Bt + (size_t)nxt.pn * tstep : cB;
        for (int t = 0; t < nt; t += 2) {
            const bool last = (t == nt - 2);
            const char* a1 = cA + (size_t)(t + 1) * kstep;
            const char* a2 = last ? nA : cA + (size_t)(t + 2) * kstep; const char* b2 = last ? nB : cB + (size_t)(t + 2) * kstep;
            const char* a3 = a2 + kstep; const char* b3 = b2 + kstep;
            if (last && has_next) S.a_ready(nxt);
            if constexpr (SP2) {
            PG8_LDB(B0, 0, 0); PG8_LDB(B1, 0, 1); PG8_SCHED; PG8_LDA(At, 0, 0); PG8_STAGE(PG8_SA(1, 1), a1 + hstep, voffA);
            PG8_WAIT_V(8); PG8_WAIT_L(0); PG8_BAR; PG8_MMA(0, 0, At, B0); PG8_MMA(0, 1, At, B1); PG8_BAR; PG8_SCHED;
            PG8_LDA(At, 0, 1); PG8_STAGE(PG8_SB(0, 0), b2, voffB); PG8_STAGE(PG8_SB(0, 1), b2 + hstep, voffB); PG8_STAGE(PG8_SA(0, 0), a2, voffA);
            PG8_WAIT_V(8); PG8_WAIT_L(0); PG8_BAR; PG8_MMA(1, 0, At, B0); PG8_MMA(1, 1, At, B1); PG8_BAR; PG8_SCHED;
            PG8_LDB(B0, 1, 0); PG8_LDB(B1, 1, 1); PG8_SCHED; PG8_LDA(At, 1, 0); PG8_STAGE(PG8_SA(0, 1), a2 + hstep, voffA);
            PG8_WAIT_V(8); PG8_WAIT_L(0); PG8_BAR; PG8_MMA(0, 0, At, B0); PG8_MMA(0, 1, At, B1); PG8_BAR; PG8_SCHED;
            PG8_LDA(At, 1, 1); PG8_STAGE(PG8_SB(1, 0), b3, voffB); PG8_STAGE(PG8_SB(1, 1), b3 + hstep, voffB); PG8_STAGE(PG8_SA(1, 0), a3, voffA);
            PG8_WAIT_V(8); PG8_WAIT_L(0); PG8_BAR; PG8_MMA(1, 0, At, B0); PG8_MMA(1, 1, At, B1); PG8_BAR; PG8_SCHED;
            } else {
            PG8_LDB(B0, 0, 0); PG8_SCHED; PG8_LDA(At, 0, 0); PG8_STAGE(PG8_SA(1, 1), a1 + hstep, voffA);
            PG8_WAIT_L(8); PG8_BAR; PG8_WAIT_L(0); PG8_MMA(0, 0, At, B0); PG8_BAR; PG8_SCHED;
            PG8_LDB(B1, 0, 1); PG8_STAGE(PG8_SB(0, 0), b2, voffB);
            PG8_BAR; PG8_WAIT_L(0); PG8_MMA(0, 1, At, B1); PG8_BAR;
            PG8_LDA(At, 0, 1); PG8_STAGE(PG8_SA(0, 0), a2, voffA);
            PG8_BAR; PG8_WAIT_L(0); PG8_MMA(1, 0, At, B0); PG8_BAR; PG8_SCHED;
            PG8_STAGE(PG8_SB(0, 1), b2 + hstep, voffB);
            PG8_WAIT_V(6); PG8_BAR; PG8_MMA(1, 1, At, B1); PG8_BAR;
            PG8_LDB(B0, 1, 0); PG8_SCHED; PG8_LDA(At, 1, 0); PG8_STAGE(PG8_SA(0, 1), a2 + hstep, voffA);
            PG8_WAIT_L(8); PG8_BAR; PG8_WAIT_L(0); PG8_MMA(0, 0, At, B0); PG8_BAR; PG8_SCHED;
            PG8_LDB(B1, 1, 1); PG8_STAGE(PG8_SB(1, 0), b3, voffB);
            PG8_BAR; PG8_WAIT_L(0); PG8_MMA(0, 1, At, B1); PG8_BAR;
            PG8_LDA(At, 1, 1); PG8_STAGE(PG8_SA(1, 0), a3, voffA);
            PG8_BAR; PG8_WAIT_L(0); PG8_MMA(1, 0, At, B0); PG8_BAR; PG8_SCHED;
            PG8_STAGE(PG8_SB(1, 1), b3 + hstep, voffB);
            PG8_WAIT_V(6); PG8_BAR; PG8_MMA(1, 1, At, B1); PG8_BAR;
            }
        }
        if constexpr (ALIGN_EPI) { if (wr == 0) PG8_BAR; }
        E(acc, cur, wr, wc, fr, fq); S.done(cur);
        if (!has_next) break;
#pragma unroll
        for (int a = 0; a < 2; ++a)
#pragma unroll
            for (int b = 0; b < 2; ++b)
#pragma unroll
                for (int m = 0; m < 4; ++m)
#pragma unroll
                    for (int n = 0; n < 2; ++n) acc[a][b][m][n] = (f32x4){0.f, 0.f, 0.f, 0.f};
        cur = nxt; cA = nA; cB = nB; ++ui;
        if constexpr (ALIGN_EPI) { if (wr == 1) PG8_BAR; }
    }
    PG8_WAIT_V(0);
    if constexpr (!ALIGN_EPI) { if (wr == 0) PG8_BAR; }
    PG8_BAR;
#undef PG8_SA
#undef PG8_SB
#undef PG8_STAGE
#undef PG8_LDA
#undef PG8_LDB
#undef PG8_MMA
#undef PG8_WAIT_V
#undef PG8_WAIT_L
#undef PG8_BAR
#undef PG8_SCHED
}
}

#define PG8_SP2 true
#define PG8_ALIGN true

constexpr int NWAVES = 8;
constexpr int BATCH = 32, SEQ = 2048, DM = 1024, MTOK = BATCH * SEQ, DFF = 2816, NFF = 2 * DFF, DIN = 3072;
constexpr int DRNN = 512, NRB = 8, RB = 64, NHEAD = 4, DH = 128, CHUNK = 128, NCHUNK = SEQ / CHUNK, DEPTH = 2;
constexpr float EPS = 1e-6f;

constexpr size_t MiB = 1u << 20;
constexpr size_t WS_CTL = 0, CTL_ZERO_BYTES = 1 * MiB;
constexpr size_t SZ_WFIN = (size_t)NFF * DM * 2, SZ_WFOUT = (size_t)DM * DFF * 2, SZ_WIN = (size_t)DIN * DM * 2, SZ_WOUT = (size_t)DM * DM * 2;
constexpr size_t OFF_W1IN = 0, OFF_W1OUT = OFF_W1IN + SZ_WFIN, OFF_WIN = OFF_W1OUT + SZ_WFOUT, OFF_WOUT = OFF_WIN + SZ_WIN, OFF_W2IN = OFF_WOUT + SZ_WOUT, OFF_W2OUT = OFF_W2IN + SZ_WFIN;
constexpr size_t SZ_WLAYER = OFF_W2OUT + SZ_WFOUT;
constexpr size_t WS_W = 2 * MiB;
constexpr size_t WS_XB = 96 * MiB;
constexpr size_t WS_SS = 224 * MiB;
constexpr size_t WS_Y = 232 * MiB;
constexpr size_t WS_PH = 360 * MiB;
constexpr size_t WS_END = 744 * MiB;
static_assert(WS_W + 2 * SZ_WLAYER <= WS_XB, "weights fit");
constexpr int CW_BAR = 4096;

constexpr int LDS_BYTES = 147456;
constexpr int MISC_OFF = LDS_BYTES - 64;

#define LAS __attribute__((address_space(3)))
typedef unsigned short bf16;
typedef unsigned v4u __attribute__((ext_vector_type(4)));
typedef unsigned v2u __attribute__((ext_vector_type(2)));
typedef float f32x4 __attribute__((ext_vector_type(4)));
typedef short bf16x8 __attribute__((ext_vector_type(8)));
typedef short bf16x4 __attribute__((ext_vector_type(4)));
#define LDS_WAIT() asm volatile("s_waitcnt lgkmcnt(0)" ::: "memory")
#define VM_WAIT() asm volatile("s_waitcnt vmcnt(0)" ::: "memory")
#define LDS_BARRIER() do { asm volatile("s_waitcnt lgkmcnt(0)" ::: "memory"); __builtin_amdgcn_s_barrier(); asm volatile("" ::: "memory"); } while (0)
__device__ __forceinline__ unsigned f2bf(float f) { unsigned u = __builtin_bit_cast(unsigned, f); return (u + 0x7fffu + ((u >> 16) & 1u)) >> 16; }
__device__ __forceinline__ unsigned pk2(float lo, float hi) { return f2bf(lo) | (f2bf(hi) << 16); }
__device__ __forceinline__ float bf2f(unsigned b) { return __builtin_bit_cast(float, b << 16); }
__device__ __forceinline__ float bflo(unsigned w) { return __builtin_bit_cast(float, w << 16); }
__device__ __forceinline__ float bfhi(unsigned w) { return __builtin_bit_cast(float, w & 0xffff0000u); }

#define XB_TMO      128
#define XB_XCNT(j)  (256  + 64 * (j))
#define XB_XSUB(j)  (1280 + 64 * (j))
#define XB_XGEN(j)  (2304 + 64 * (j))
#define XB_TOP      3328
#define XB_TOPGEN   3392
#define XCD_BAR_WORDS 3456
#define XB_SPIN_CAP (1u << 18)

__device__ __forceinline__ unsigned xb_ld(unsigned* p)              { return __hip_atomic_load(p, __ATOMIC_RELAXED, __HIP_MEMORY_SCOPE_AGENT); }
__device__ __forceinline__ unsigned xb_add(unsigned* p, unsigned v) { return __hip_atomic_fetch_add(p, v, __ATOMIC_RELAXED, __HIP_MEMORY_SCOPE_AGENT); }
__device__ __forceinline__ unsigned xb_xcc_id() { return (unsigned)__builtin_amdgcn_s_getreg((3 << 11) | 20) & 0xFu; }
#define XB_SPIN(cond, bar) do { unsigned _sp = 0; while (cond) { __builtin_amdgcn_s_sleep(1); \
    if ((++_sp & 255u) == 0u) { if (xb_ld(&(bar)[XB_TMO])) break; if (_sp > XB_SPIN_CAP) { atomicAdd(&(bar)[XB_TMO], 1u); break; } } } } while (0)

struct XcdBarrier {
    unsigned* bar; unsigned x;
    volatile LAS unsigned* st;
};
__device__ __forceinline__ XcdBarrier xcd_barrier_post(unsigned* bar, volatile LAS unsigned* st) {
    XcdBarrier b; b.bar = bar; b.x = xb_xcc_id(); b.st = st;
    if (threadIdx.x == 0) (void)xb_add(&bar[XB_XCNT(b.x)], 1u);
    return b;
}
__device__ __forceinline__ void xcd_barrier_complete(unsigned* bar, unsigned x, unsigned& nloc, unsigned& nx) {
    const unsigned G = gridDim.x * gridDim.y * gridDim.z;
    unsigned sum, cnt, mine, sp = 0u;
    for (;;) {
        sum = 0u; cnt = 0u; mine = 0u;
#pragma unroll
        for (unsigned j = 0; j < 16; ++j) { const unsigned c = xb_ld(&bar[XB_XCNT(j)]); sum += c; cnt += (c > 0u) ? 1u : 0u; mine = (j == x) ? c : mine; }
        if (sum == G) break;
        __builtin_amdgcn_s_sleep(1);
        if ((++sp & 255u) == 0u) { if (xb_ld(&bar[XB_TMO])) break; if (sp > XB_SPIN_CAP) { atomicAdd(&bar[XB_TMO], 1u); break; } }
    }
    nloc = mine > 0u ? mine : 1u; nx = cnt > 0u ? cnt : 1u;
}
__device__ __forceinline__ void xcd_barrier(const XcdBarrier& b) {
    asm volatile("s_waitcnt vmcnt(0)" ::: "memory");
    __syncthreads();
    if (threadIdx.x == 0) {
        unsigned* bar = b.bar; asm volatile("" : "+s"(bar));
        __builtin_amdgcn_s_waitcnt(0);
        unsigned nloc = b.st[0], nx = b.st[1];
        if (nloc == 0u) { xcd_barrier_complete(bar, b.x, nloc, nx); b.st[0] = nloc; b.st[1] = nx; }
        const unsigned old = xb_add(&bar[XB_XSUB(b.x)], 1u);
        const unsigned gen = old / nloc;
        if (old + 1u == (gen + 1u) * nloc) {
            __builtin_amdgcn_fence(__ATOMIC_RELEASE, "agent");
            asm volatile("s_waitcnt vmcnt(0)" ::: "memory");
            const unsigned og = xb_add(&bar[XB_TOP], 1u);
            const unsigned tg = og / nx;
            if (og + 1u == (tg + 1u) * nx) xb_add(&bar[XB_TOPGEN], 1u);
            else XB_SPIN(xb_ld(&bar[XB_TOPGEN]) == tg, bar);
            __builtin_amdgcn_fence(__ATOMIC_ACQUIRE, "agent");
            xb_add(&bar[XB_XGEN(b.x)], 1u);
            asm volatile("s_waitcnt vmcnt(0)" ::: "memory");
        } else {
            XB_SPIN(xb_ld(&bar[XB_XGEN(b.x)]) == gen, bar);
            __builtin_amdgcn_fence(__ATOMIC_ACQUIRE, "agent");
            asm volatile("s_waitcnt vmcnt(0)" ::: "memory");
        }
    }
    __syncthreads();
}

__device__ __forceinline__ float row_scale(const float* ss, int row) {
    const f32x4* p = (const f32x4*)(ss + (size_t)row * 16);
    const f32x4 a = p[0], b = p[1], c = p[2], d = p[3];
    const float s = ((a[0] + a[1]) + (a[2] + a[3])) + ((b[0] + b[1]) + (b[2] + b[3])) + ((c[0] + c[1]) + (c[2] + c[3])) + ((d[0] + d[1]) + (d[2] + d[3]));
    return rsqrtf(s * (1.0f / DM) + EPS);
}
__device__ __forceinline__ float sigmoid_f(float v) { return __builtin_amdgcn_rcpf(1.0f + __builtin_amdgcn_exp2f(-1.44269504f * v)); }
__device__ __forceinline__ float silu_f(float v) { return v * sigmoid_f(v); }
__device__ __forceinline__ float gelu_tanh_f(float v) { const float z = 1.5957691216f * (v + 0.044715f * v * v * v); return v * sigmoid_f(z); }

struct EpiSwiGLU {
    static constexpr bool PERM = true, AFTER_DRAIN = false;
    pg8::bf16_t* H; const float* ss;
    __device__ __forceinline__ void operator()(const pg8::f32x4 (&acc)[2][2][4][2], const pg8::Unit& u, int wr, int wc, int fr, int fq) const {
        const int row0 = u.pm * 256 + wr * 64 + fr, col0 = u.pn * 128 + wc * 32 + 8 * fq;
#pragma unroll
        for (int ai = 0; ai < 2; ++ai)
#pragma unroll
            for (int m = 0; m < 4; ++m) {
                const int row = row0 + ai * 128 + m * 16; const float rs = row_scale(ss, row);
                float o[8];
#pragma unroll
                for (int n = 0; n < 2; ++n)
#pragma unroll
                    for (int i = 0; i < 4; ++i) { const float g = acc[ai][0][m][n][i] * rs, up = acc[ai][1][m][n][i] * rs; o[n * 4 + i] = silu_f(g) * up; }
                pg8::u32x4 w; w.x = pg8::cvt_pk_bf16(o[0], o[1]); w.y = pg8::cvt_pk_bf16(o[2], o[3]); w.z = pg8::cvt_pk_bf16(o[4], o[5]); w.w = pg8::cvt_pk_bf16(o[6], o[7]);
                *(pg8::u32x4*)(H + (size_t)row * DFF + col0) = w;
            }
    }
};
struct EpiResid {
    static constexpr bool PERM = true, AFTER_DRAIN = false;
    const float* xin32; pg8::bf16_t* xb; float* ss; float alpha;
    __device__ __forceinline__ void operator()(const pg8::f32x4 (&acc)[2][2][4][2], const pg8::Unit& u, int wr, int wc, int fr, int fq) const {
        const int row0 = u.pm * 256 + wr * 64 + fr, col0 = u.pn * 256 + wc * 32 + 8 * fq;
#pragma unroll
        for (int ai = 0; ai < 2; ++ai)
#pragma unroll
            for (int m = 0; m < 4; ++m) {
                const int row = row0 + ai * 128 + m * 16; float sq = 0.f;
#pragma unroll
                for (int bj = 0; bj < 2; ++bj) {
                    const size_t off = (size_t)row * DM + col0 + bj * 128;
                    pg8::f32x4 o0, o1;
                    if (xin32) { o0 = *(const pg8::f32x4*)(xin32 + off); o1 = *(const pg8::f32x4*)(xin32 + off + 4); }
                    else { const pg8::u32x4 xw = *(const pg8::u32x4*)(xb + off); o0 = (pg8::f32x4){bflo(xw.x), bfhi(xw.x), bflo(xw.y), bfhi(xw.y)}; o1 = (pg8::f32x4){bflo(xw.z), bfhi(xw.z), bflo(xw.w), bfhi(xw.w)}; }
                    const pg8::f32x4 v0 = o0 + acc[ai][bj][m][0] * alpha, v1 = o1 + acc[ai][bj][m][1] * alpha;
                    pg8::u32x4 w; w.x = pg8::cvt_pk_bf16(v0[0], v0[1]); w.y = pg8::cvt_pk_bf16(v0[2], v0[3]); w.z = pg8::cvt_pk_bf16(v1[0], v1[1]); w.w = pg8::cvt_pk_bf16(v1[2], v1[3]);
                    *(pg8::u32x4*)(xb + off) = w;
                    const float r0 = bflo(w.x), r1 = bfhi(w.x), r2 = bflo(w.y), r3 = bfhi(w.y), r4 = bflo(w.z), r5 = bfhi(w.z), r6 = bflo(w.w), r7 = bfhi(w.w);
                    sq += (r0 * r0 + r1 * r1) + (r2 * r2 + r3 * r3) + (r4 * r4 + r5 * r5) + (r6 * r6 + r7 * r7);
                }
                sq += __shfl_xor(sq, 16); sq += __shfl_xor(sq, 32);
                if (fq == 0) ss[(size_t)row * 16 + 4 * u.pn + wc] = sq;
            }
    }
};
struct EpiProj {
    static constexpr bool PERM = true, AFTER_DRAIN = false;
    pg8::bf16_t* P; const float* ss; const int* pos;
    __device__ __forceinline__ void operator()(const pg8::f32x4 (&acc)[2][2][4][2], const pg8::Unit& u, int wr, int wc, int fr, int fq) const {
        const int row0 = u.pm * 256 + wr * 64 + fr; const int pn = u.pn;
        if (pn >= 4 && pn < 8) {
            const int jj0 = 32 * (wc & 1) + 8 * fq; const float ksc = (pn >= 6) ? 0.08838834764831845f : 1.0f;
            const size_t cbase = (size_t)256 * pn + 128 * (wc >> 1) + jj0;
#pragma unroll
            for (int ai = 0; ai < 2; ++ai)
#pragma unroll
                for (int m = 0; m < 4; ++m) {
                    const int row = row0 + ai * 128 + m * 16; const float rs = row_scale(ss, row) * ksc; const float p = (float)pos[row];
                    float o1[8], o2[8];
#pragma unroll
                    for (int n = 0; n < 2; ++n)
#pragma unroll
                        for (int i = 0; i < 4; ++i) {
                            const float inv = __builtin_amdgcn_exp2f(-(float)(jj0 + n * 4 + i) * 0.20762050593046014f) * 0.15915494309189535f;
                            float rev = p * inv; rev = rev - floorf(rev);
                            const float sn = __builtin_amdgcn_sinf(rev), cs = __builtin_amdgcn_cosf(rev);
                            const float t1 = acc[ai][0][m][n][i] * rs, t2 = acc[ai][1][m][n][i] * rs;
                            o1[n * 4 + i] = t1 * cs - t2 * sn; o2[n * 4 + i] = t1 * sn + t2 * cs;
                        }
                    pg8::u32x4 w1, w2;
                    w1.x = pg8::cvt_pk_bf16(o1[0], o1[1]); w1.y = pg8::cvt_pk_bf16(o1[2], o1[3]); w1.z = pg8::cvt_pk_bf16(o1[4], o1[5]); w1.w = pg8::cvt_pk_bf16(o1[6], o1[7]);
                    w2.x = pg8::cvt_pk_bf16(o2[0], o2[1]); w2.y = pg8::cvt_pk_bf16(o2[2], o2[3]); w2.z = pg8::cvt_pk_bf16(o2[4], o2[5]); w2.w = pg8::cvt_pk_bf16(o2[6], o2[7]);
                    *(pg8::u32x4*)(P + (size_t)row * DIN + cbase) = w1; *(pg8::u32x4*)(P + (size_t)row * DIN + cbase + 64) = w2;
                }
        } else {
            const int act = (pn == 2 || pn == 3) ? 1 : (pn >= 10 ? 2 : 0);
            const int col0 = pn * 256 + wc * 32 + 8 * fq;
#pragma unroll
            for (int ai = 0; ai < 2; ++ai)
#pragma unroll
                for (int m = 0; m < 4; ++m) {
                    const int row = row0 + ai * 128 + m * 16; const float rs = row_scale(ss, row);
#pragma unroll
                    for (int bj = 0; bj < 2; ++bj) {
                        float o[8];
#pragma unroll
                        for (int n = 0; n < 2; ++n)
#pragma unroll
                            for (int i = 0; i < 4; ++i) { const float v = acc[ai][bj][m][n][i] * rs; o[n * 4 + i] = act == 1 ? gelu_tanh_f(v) : (act == 2 ? silu_f(v) : v); }
                        pg8::u32x4 w; w.x = pg8::cvt_pk_bf16(o[0], o[1]); w.y = pg8::cvt_pk_bf16(o[2], o[3]); w.z = pg8::cvt_pk_bf16(o[4], o[5]); w.w = pg8::cvt_pk_bf16(o[6], o[7]);
                        *(pg8::u32x4*)(P + (size_t)row * DIN + col0 + bj * 128) = w;
                    }
                }
        }
    }
};

struct Args { const void* in[19]; float* out; unsigned char* ws; int ph_lo, ph_hi, dry, pad; };
static_assert(sizeof(Args) == 184 && __builtin_offsetof(Args, out) == 152 && __builtin_offsetof(Args, ws) == 160 && __builtin_offsetof(Args, ph_lo) == 168 && __builtin_offsetof(Args, dry) == 176, "KA offsets");
#define CAS __attribute__((address_space(4)))
struct KA {
    static __device__ __forceinline__ const CAS char* base() { const CAS char* kp = (const CAS char*)__builtin_amdgcn_kernarg_segment_ptr(); asm volatile("" : "+s"(kp)); return kp; }
    static __device__ __forceinline__ const void* in(int k) { return *(const void* const CAS*)(base() + 8 * k); }
    static __device__ __forceinline__ float* out() { return *(float* const CAS*)(base() + 152); }
    static __device__ __forceinline__ unsigned char* ws() { return *(unsigned char* const CAS*)(base() + 160); }
    static __device__ __forceinline__ int lo() { return *(const CAS int*)(base() + 168); }
    static __device__ __forceinline__ int hi() { return *(const CAS int*)(base() + 172); }
    static __device__ __forceinline__ int dry() { return *(const CAS int*)(base() + 176); }
};
struct Frame {
    LAS unsigned char* lds;
    int tid, lane, wave, G;
};
__device__ __forceinline__ float wave_sum(float v) {
#pragma unroll
    for (int o = 1; o < 64; o <<= 1) v += __shfl_xor(v, o);
    return v;
}

__device__ __forceinline__ void transpose_item(const float* W, int K, int Nsrc, const float* gain, bf16* WT, int k0, int ndst0, int nsrc0, LAS float* scr, int lane) {
#pragma unroll 8
    for (int i = 0; i < 32; ++i) { const int kk = 2 * i + (lane >> 5); const float gk = gain ? gain[k0 + kk] : 1.0f; scr[kk * 33 + (lane & 31)] = W[(size_t)(k0 + kk) * Nsrc + nsrc0 + (lane & 31)] * gk; }
    LDS_WAIT(); asm volatile("" ::: "memory");
    const int c = lane & 7;
#pragma unroll
    for (int j = 0; j < 4; ++j) { const int n = (lane >> 3) + 8 * j; const LAS float* s = scr + (8 * c) * 33 + n;
        v4u o; o.x = pk2(s[0 * 33], s[1 * 33]); o.y = pk2(s[2 * 33], s[3 * 33]); o.z = pk2(s[4 * 33], s[5 * 33]); o.w = pk2(s[6 * 33], s[7 * 33]);
        *(v4u*)(WT + (size_t)(ndst0 + n) * K + k0 + 8 * c) = o; }
    LDS_WAIT(); asm volatile("" ::: "memory");
}
__device__ __forceinline__ int map_ffn(int n) { const int pn = n >> 8, bj = (n >> 7) & 1, c = n & 127; return bj * DFF + 128 * pn + c; }
__device__ __forceinline__ int map_proj(int n) { const int pn = n >> 8; if (pn < 4 || pn >= 8) return n; const int bj = (n >> 7) & 1, cc = n & 127; return 256 * pn + 128 * (cc >> 6) + 64 * bj + (cc & 63); }

__device__ __forceinline__ void phase_prep(const Frame& F, const Args& a) {
    LAS float* scr = (LAS float*)(F.lds + F.wave * 16384);
    const int gw = blockIdx.x * NWAVES + F.wave, NGW = F.G * NWAVES;
    constexpr int I_FIN = (DM / 64) * (NFF / 32), I_FOUT = (DFF / 64) * (DM / 32), I_IN = (DM / 64) * (DIN / 32), I_OUT = (DM / 64) * (DM / 32);
    constexpr int I_LAYER = 2 * I_FIN + 2 * I_FOUT + I_IN + I_OUT;
    for (int it = gw; it < DEPTH * I_LAYER; it += NGW) {
        const int l = it / I_LAYER; int r = it % I_LAYER;
        unsigned char* wl = KA::ws() + WS_W + (size_t)l * SZ_WLAYER;
        const float* W; const float* gain; bf16* WT; int K, N, mode;
        if (r < I_FIN) { W = (const float*)KA::in(3) + (size_t)l * DM * NFF; gain = (const float*)KA::in(2) + l * DM; WT = (bf16*)(wl + OFF_W1IN); K = DM; N = NFF; mode = 1; }
        else if ((r -= I_FIN) < I_FOUT) { W = (const float*)KA::in(4) + (size_t)l * DFF * DM; gain = nullptr; WT = (bf16*)(wl + OFF_W1OUT); K = DFF; N = DM; mode = 0; }
        else if ((r -= I_FOUT) < I_IN) { W = (const float*)KA::in(6) + (size_t)l * DM * DIN; gain = (const float*)KA::in(5) + l * DM; WT = (bf16*)(wl + OFF_WIN); K = DM; N = DIN; mode = 2; }
        else if ((r -= I_IN) < I_OUT) { W = (const float*)KA::in(14) + (size_t)l * DM * DM; gain = nullptr; WT = (bf16*)(wl + OFF_WOUT); K = DM; N = DM; mode = 0; }
        else if ((r -= I_OUT) < I_FIN) { W = (const float*)KA::in(16) + (size_t)l * DM * NFF; gain = (const float*)KA::in(15) + l * DM; WT = (bf16*)(wl + OFF_W2IN); K = DM; N = NFF; mode = 1; }
        else { r -= I_FIN; W = (const float*)KA::in(17) + (size_t)l * DFF * DM; gain = nullptr; WT = (bf16*)(wl + OFF_W2OUT); K = DFF; N = DM; mode = 0; }
        const int nblk = N / 32, kb = r / nblk, nb = r % nblk, n0 = 32 * nb;
        const int ns0 = mode == 1 ? map_ffn(n0) : (mode == 2 ? map_proj(n0) : n0);
        transpose_item(W, K, N, gain, WT, 64 * kb, n0, ns0, scr, F.lane);
    }
    const float* x = (const float*)KA::in(0); bf16* xb = (bf16*)(KA::ws() + WS_XB); float* ss = (float*)(KA::ws() + WS_SS);
    for (int m = gw; m < MTOK; m += NGW) {
        const f32x4* xr = (const f32x4*)(x + (size_t)m * DM) + F.lane; f32x4 v[4]; float s = 0.f;
#pragma unroll
        for (int j = 0; j < 4; ++j) { v[j] = xr[64 * j]; s += (v[j][0] * v[j][0] + v[j][1] * v[j][1]) + (v[j][2] * v[j][2] + v[j][3] * v[j][3]); }
        s = wave_sum(s);
        v2u* o8 = (v2u*)(xb + (size_t)m * DM) + F.lane;
#pragma unroll
        for (int j = 0; j < 4; ++j) { v2u w; w.x = pk2(v[j][0], v[j][1]); w.y = pk2(v[j][2], v[j][3]); o8[64 * j] = w; }
        if (F.lane < 16) ss[(size_t)m * 16 + F.lane] = F.lane == 0 ? s : 0.f;
    }
}
__device__ __forceinline__ void phase_final(const Frame& F, const Args& a) {
    const int gw = blockIdx.x * NWAVES + F.wave, NGW = F.G * NWAVES;
    const bf16* xb = (const bf16*)(KA::ws() + WS_XB); float* out = KA::out();
    const f32x4* gp = (const f32x4*)KA::in(18) + 2 * F.lane; f32x4 gn[4];
#pragma unroll
    for (int j = 0; j < 2; ++j) { gn[2 * j] = gp[128 * j]; gn[2 * j + 1] = gp[128 * j + 1]; }
    for (int m = gw; m < MTOK; m += NGW) {
        const v4u* xr = (const v4u*)(xb + (size_t)m * DM) + F.lane; f32x4 v[4]; float s = 0.f;
#pragma unroll
        for (int j = 0; j < 2; ++j) { const v4u w = xr[64 * j];
            v[2 * j] = (f32x4){bflo(w.x), bfhi(w.x), bflo(w.y), bfhi(w.y)}; v[2 * j + 1] = (f32x4){bflo(w.z), bfhi(w.z), bflo(w.w), bfhi(w.w)}; }
#pragma unroll
        for (int j = 0; j < 4; ++j) s += (v[j][0] * v[j][0] + v[j][1] * v[j][1]) + (v[j][2] * v[j][2] + v[j][3] * v[j][3]);
        s = wave_sum(s); const float rs = rsqrtf(s * (1.0f / DM) + EPS);
        f32x4* orow = (f32x4*)(out + (size_t)m * DM) + 2 * F.lane;
#pragma unroll
        for (int j = 0; j < 2; ++j) { orow[128 * j] = v[2 * j] * rs * gn[2 * j]; orow[128 * j + 1] = v[2 * j + 1] * rs * gn[2 * j + 1]; }
    }
}

constexpr int L_WA = 0, L_WX = 9216, L_RAW = 18432, L_XCB = 35200, L_XCF = 53632, L_AA = 86400, L_CAR = 119168, L_END = 123264;
static_assert(L_END <= MISC_OFF, "lru lds");
__device__ __forceinline__ void lru_unit(const Frame& F, const Args& a, int layer, int b, int j) {
    LAS unsigned char* lds = F.lds;
    int tid0 = F.tid; asm volatile("" : "+v"(tid0));
    const bf16* P = (const bf16*)(KA::ws() + WS_PH); bf16* Y = (bf16*)(KA::ws() + WS_Y);
    const float* gaw = (const float*)KA::in(9) + ((size_t)layer * NRB + j) * RB * RB; const float* gxw = (const float*)KA::in(11) + ((size_t)layer * NRB + j) * RB * RB;
    const float* gab = (const float*)KA::in(10) + layer * DRNN + j * RB; const float* gxb = (const float*)KA::in(12) + layer * DRNN + j * RB;
    const float* lam = (const float*)KA::in(13) + layer * DRNN + j * RB;
    const float* cw = (const float*)KA::in(7) + (size_t)layer * 4 * DRNN + j * RB; const float* cb = (const float*)KA::in(8) + layer * DRNN + j * RB;
    __syncthreads();
#pragma unroll
    for (int r = 0; r < 8; ++r) { const int e = tid0 + 512 * r, i = e >> 6, o = e & 63;
        ((LAS bf16*)(lds + L_WA))[o * 72 + i] = (bf16)f2bf(gaw[e]); ((LAS bf16*)(lds + L_WX))[o * 72 + i] = (bf16)f2bf(gxw[e]); }
    const int cc0 = tid0 & 63;
    float cwk[4];
#pragma unroll
    for (int k = 0; k < 4; ++k) cwk[k] = cw[k * DRNN + cc0];
    const float cbias = cb[cc0];
    float ba[4], bx[4], cl[4];
#pragma unroll
    for (int ob = 0; ob < 4; ++ob) { const int o = 16 * ob + (tid0 & 15); ba[ob] = gab[o]; bx[ob] = gxb[o];
        const float nl = -lam[o]; const float sp = (nl > 20.f) ? nl : log1pf(__expf(nl));
        cl[ob] = -8.0f * sp * 1.44269504f; }
    float hcar = 0.f;
    for (int step = 0; step < SEQ / 128; ++step) {
        const int t0 = step * 128;
        int tid = tid0, w = F.wave; asm volatile("" : "+v"(tid)); asm volatile("" : "+s"(w));
        const int lane = tid & 63, col = lane & 15, q = lane >> 4, cc = tid & 63;
        __syncthreads();
#pragma unroll
        for (int r = 0; r < 3; ++r) { const int p = tid + 512 * r; if (p < 131 * 8) { const int row = p >> 3, seg = p & 7, tok = t0 - 3 + row;
            v4u v = (v4u){0u, 0u, 0u, 0u}; if (tok >= 0) v = *(const v4u*)(P + (size_t)(b * SEQ + tok) * DIN + j * RB + 8 * seg);
            *(LAS v4u*)(lds + L_RAW + row * 128 + seg * 16) = v; } }
        __syncthreads();
#pragma unroll
        for (int r = 0; r < 16; ++r) { const int e = tid + 512 * r, t = e >> 6;
            float xc = cbias;
#pragma unroll
            for (int k = 0; k < 4; ++k) xc += cwk[k] * bf2f(((const LAS bf16*)(lds + L_RAW))[(t + k) * 64 + cc]);
            ((LAS float*)(lds + L_XCF))[t * 64 + cc] = xc; ((LAS bf16*)(lds + L_XCB))[t * 72 + cc] = (bf16)f2bf(xc); }
        __syncthreads();
        {
            bf16x8 af[2];
#pragma unroll
            for (int s = 0; s < 2; ++s) af[s] = *(const LAS bf16x8*)(lds + L_XCB + ((16 * w + col) * 72 + 32 * s + 8 * q) * 2);
#pragma unroll
            for (int ob = 0; ob < 4; ++ob) {
                f32x4 za = (f32x4){0.f, 0.f, 0.f, 0.f}, zx = (f32x4){0.f, 0.f, 0.f, 0.f};
#pragma unroll
                for (int s = 0; s < 2; ++s) {
                    const bf16x8 wa = *(const LAS bf16x8*)(lds + L_WA + ((16 * ob + col) * 72 + 32 * s + 8 * q) * 2);
                    const bf16x8 wx = *(const LAS bf16x8*)(lds + L_WX + ((16 * ob + col) * 72 + 32 * s + 8 * q) * 2);
                    za = __builtin_amdgcn_mfma_f32_16x16x32_bf16(af[s], wa, za, 0, 0, 0);
                    zx = __builtin_amdgcn_mfma_f32_16x16x32_bf16(af[s], wx, zx, 0, 0, 0);
                }
#pragma unroll
                for (int r = 0; r < 4; ++r) { const int tok = 16 * w + 4 * q + r, o = 16 * ob + col;
                    const float ra = sigmoid_f(za[r] + ba[ob]), ri = sigmoid_f(zx[r] + bx[ob]);
                    const float av = __builtin_amdgcn_exp2f(cl[ob] * ra);
                    const float xc = ((const LAS float*)(lds + L_XCF))[tok * 64 + o];
                    const float uu = sqrtf(fmaxf(1.0f - av * av, 0.f)) * ri * xc;
                    ((LAS float*)(lds + L_AA))[tok * 64 + o] = av; ((LAS float*)(lds + L_XCF))[tok * 64 + o] = uu; }
            }
        }
        LDS_WAIT();
        {
            float h = 0.f, p = 1.f;
#pragma unroll
            for (int t = 0; t < 16; ++t) { const int idx = (16 * w + t) * 64 + lane;
                const float av = ((const LAS float*)(lds + L_AA))[idx], uu = ((const LAS float*)(lds + L_XCF))[idx];
                h = av * h + uu; p = p * av;
                ((LAS float*)(lds + L_XCF))[idx] = h; ((LAS float*)(lds + L_AA))[idx] = p; }
            ((LAS float*)(lds + L_CAR))[(w * 2 + 0) * 64 + lane] = p; ((LAS float*)(lds + L_CAR))[(w * 2 + 1) * 64 + lane] = h;
        }
        __syncthreads();
        {
            float hin = hcar, hall = hcar;
#pragma unroll
            for (int w2 = 0; w2 < 8; ++w2) { const float pp = ((const LAS float*)(lds + L_CAR))[(w2 * 2 + 0) * 64 + lane], hh = ((const LAS float*)(lds + L_CAR))[(w2 * 2 + 1) * 64 + lane];
                hall = pp * hall + hh; if (w2 < w) hin = pp * hin + hh; }
            hcar = hall;
#pragma unroll
            for (int t = 0; t < 16; ++t) { const int idx = (16 * w + t) * 64 + lane;
                const float h = ((const LAS float*)(lds + L_XCF))[idx] + ((const LAS float*)(lds + L_AA))[idx] * hin;
                const size_t row = (size_t)(b * SEQ + t0 + 16 * w + t);
                const float g = bf2f(P[row * DIN + DRNN + j * RB + lane]);
                Y[row * DM + j * RB + lane] = (bf16)f2bf(h * g); }
        }
    }
}

constexpr int RS = 136;
constexpr int R_KI = 0, R_KT = 34816, R_VT = 69632, R_PT = 104448, R_END = 139264;
static_assert(R_END <= MISC_OFF, "retention lds");
__device__ __forceinline__ void ret_unit(const Frame& F, const Args& a, int b, int hh) {
    LAS unsigned char* lds = F.lds;
    const bf16* P = (const bf16*)(KA::ws() + WS_PH); bf16* Y = (bf16*)(KA::ws() + WS_Y);
    const float gamma = 1.0f - __builtin_amdgcn_exp2f(-5.0f - (float)hh); const float lg = __builtin_amdgcn_logf(gamma);
    const float cdecay = __builtin_amdgcn_exp2f(128.0f * lg);
    f32x4 kvacc[8];
#pragma unroll
    for (int d = 0; d < 8; ++d) kvacc[d] = (f32x4){0.f, 0.f, 0.f, 0.f};
    for (int n = 0; n < NCHUNK; ++n) {
        int tid = F.tid, w = F.wave; asm volatile("" : "+v"(tid)); asm volatile("" : "+s"(w));
        const int lane = tid & 63, col = lane & 15, q = lane >> 4;
        const size_t row0 = (size_t)b * SEQ + (size_t)n * CHUNK;
        __syncthreads();
#pragma unroll
        for (int i = 0; i < 4; ++i) { const int piece = tid + 512 * i, m = piece >> 4, d8 = piece & 15;
            const v4u kk = *(const v4u*)(P + (row0 + m) * DIN + 1536 + 128 * hh + 8 * d8);
            const v4u vv = *(const v4u*)(P + (row0 + m) * DIN + 2048 + 128 * hh + 8 * d8);
            *(LAS v4u*)(lds + R_KI + (m * RS + 8 * d8) * 2) = kk;
            const float zeta = __builtin_amdgcn_exp2f((float)(127 - m) * lg);
            const unsigned kw[4] = {kk.x, kk.y, kk.z, kk.w}, vw[4] = {vv.x, vv.y, vv.z, vv.w};
#pragma unroll
            for (int jj = 0; jj < 4; ++jj) {
                ((LAS bf16*)(lds + R_KT))[(8 * d8 + 2 * jj) * RS + m] = (bf16)f2bf(bflo(kw[jj]) * zeta);
                ((LAS bf16*)(lds + R_KT))[(8 * d8 + 2 * jj + 1) * RS + m] = (bf16)f2bf(bfhi(kw[jj]) * zeta);
                ((LAS bf16*)(lds + R_VT))[(8 * d8 + 2 * jj) * RS + m] = (bf16)(vw[jj] & 0xffffu);
                ((LAS bf16*)(lds + R_VT))[(8 * d8 + 2 * jj + 1) * RS + m] = (bf16)(vw[jj] >> 16);
            } }
#pragma unroll
        for (int db = 0; db < 8; ++db) { v2u pw; pw.x = pk2(kvacc[db][0], kvacc[db][1]); pw.y = pk2(kvacc[db][2], kvacc[db][3]);
            *(LAS v2u*)(lds + R_PT + ((16 * w + col) * RS + 16 * db + 4 * q) * 2) = pw; }
        __syncthreads();
        bf16x8 qf[4];
#pragma unroll
        for (int s = 0; s < 4; ++s) qf[s] = *(const bf16x8*)(P + (row0 + 16 * w + col) * DIN + 1024 + 128 * hh + 32 * s + 8 * q);
        f32x4 out[8];
#pragma unroll
        for (int eb = 0; eb < 8; ++eb) { f32x4 c4 = (f32x4){0.f, 0.f, 0.f, 0.f};
#pragma unroll
            for (int s = 0; s < 4; ++s) { const bf16x8 pf = *(const LAS bf16x8*)(lds + R_PT + ((16 * eb + col) * RS + 32 * s + 8 * q) * 2);
                c4 = __builtin_amdgcn_mfma_f32_16x16x32_bf16(pf, qf[s], c4, 0, 0, 0); }
            out[eb] = c4; asm volatile("" ::: "memory"); }
        {
            const float xi = __builtin_amdgcn_exp2f((float)(16 * w + col + 1) * lg);
#pragma unroll
            for (int eb = 0; eb < 8; ++eb) out[eb] = out[eb] * xi;
        }
#pragma unroll
        for (int t = 0; t < 4; ++t) {
            f32x4 sa = (f32x4){0.f, 0.f, 0.f, 0.f}, sb = (f32x4){0.f, 0.f, 0.f, 0.f};
#pragma unroll
            for (int s = 0; s < 4; ++s) {
                const bf16x8 ka = *(const LAS bf16x8*)(lds + R_KI + ((32 * t + col) * RS + 32 * s + 8 * q) * 2);
                const bf16x8 kb = *(const LAS bf16x8*)(lds + R_KI + ((32 * t + 16 + col) * RS + 32 * s + 8 * q) * 2);
                sa = __builtin_amdgcn_mfma_f32_16x16x32_bf16(ka, qf[s], sa, 0, 0, 0);
                sb = __builtin_amdgcn_mfma_f32_16x16x32_bf16(kb, qf[s], sb, 0, 0, 0);
            }
            const int c = 16 * w + col;
            float va[4], vb[4];
#pragma unroll
            for (int r = 0; r < 4; ++r) { const int ma = 32 * t + 4 * q + r, mb = ma + 16;
                va[r] = (c >= ma) ? sa[r] * __builtin_amdgcn_exp2f((float)(c - ma) * lg) : 0.f;
                vb[r] = (c >= mb) ? sb[r] * __builtin_amdgcn_exp2f((float)(c - mb) * lg) : 0.f; }
            v4u sw; sw.x = pk2(va[0], va[1]); sw.y = pk2(va[2], va[3]); sw.z = pk2(vb[0], vb[1]); sw.w = pk2(vb[2], vb[3]);
            const bf16x8 sfr = __builtin_bit_cast(bf16x8, sw);
#pragma unroll
            for (int eb = 0; eb < 8; ++eb) {
                const v2u lo = *(const LAS v2u*)(lds + R_VT + ((16 * eb + col) * RS + 32 * t + 4 * q) * 2);
                const v2u hi = *(const LAS v2u*)(lds + R_VT + ((16 * eb + col) * RS + 32 * t + 16 + 4 * q) * 2);
                const v4u vf = (v4u){lo.x, lo.y, hi.x, hi.y};
                out[eb] = __builtin_amdgcn_mfma_f32_16x16x32_bf16(__builtin_bit_cast(bf16x8, vf), sfr, out[eb], 0, 0, 0);
            }
            asm volatile("" ::: "memory");
        }
        {
            float sq = 0.f;
#pragma unroll
            for (int eb = 0; eb < 8; ++eb) sq += (out[eb][0] * out[eb][0] + out[eb][1] * out[eb][1]) + (out[eb][2] * out[eb][2] + out[eb][3] * out[eb][3]);
            sq += __shfl_xor(sq, 16); sq += __shfl_xor(sq, 32);
            const float rs = rsqrtf(sq * (1.0f / DH) + EPS);
            const size_t row = row0 + 16 * w + col;
#pragma unroll
            for (int eb = 0; eb < 8; ++eb) {
                const v2u gw2 = *(const v2u*)(P + row * DIN + 2560 + 128 * hh + 16 * eb + 4 * q);
                v2u o; o.x = pk2(out[eb][0] * rs * bflo(gw2.x), out[eb][1] * rs * bfhi(gw2.x)); o.y = pk2(out[eb][2] * rs * bflo(gw2.y), out[eb][3] * rs * bfhi(gw2.y));
                *(v2u*)(Y + row * DM + DRNN + 128 * hh + 16 * eb + 4 * q) = o;
            }
        }
        {
            bf16x8 vf[4];
#pragma unroll
            for (int t = 0; t < 4; ++t) vf[t] = *(const LAS bf16x8*)(lds + R_VT + ((16 * w + col) * RS + 32 * t + 8 * q) * 2);
#pragma unroll
            for (int db = 0; db < 8; ++db) { f32x4 c4 = kvacc[db] * cdecay;
#pragma unroll
                for (int t = 0; t < 4; ++t) { const bf16x8 kf = *(const LAS bf16x8*)(lds + R_KT + ((16 * db + col) * RS + 32 * t + 8 * q) * 2);
                    c4 = __builtin_amdgcn_mfma_f32_16x16x32_bf16(kf, vf[t], c4, 0, 0, 0); }
                kvacc[db] = c4; asm volatile("" ::: "memory"); }
        }
    }
}

typedef short s16x4 __attribute__((ext_vector_type(4)));
constexpr int RS2 = 144;
constexpr int R2_KI = 0, R2_VI = 36864, R2_PT = 73728, R2_END = 110592;
static_assert(R2_END <= MISC_OFF, "retention v2 lds");
__device__ __forceinline__ bf16x8 tr_pair(LAS unsigned char* p0, LAS unsigned char* p1) {
    const s16x4 lo = __builtin_amdgcn_ds_read_tr16_b64_v4i16((LAS s16x4*)p0), hi = __builtin_amdgcn_ds_read_tr16_b64_v4i16((LAS s16x4*)p1);
    return __builtin_shufflevector(lo, hi, 0, 1, 2, 3, 4, 5, 6, 7);
}
__device__ __forceinline__ void ret_unit2(const Frame& F, const Args& a, int b, int hh) {
    LAS unsigned char* lds = F.lds;
    const bf16* P = (const bf16*)(KA::ws() + WS_PH); bf16* Y = (bf16*)(KA::ws() + WS_Y);
    const float gamma = 1.0f - __builtin_amdgcn_exp2f(-5.0f - (float)hh); const float lg = __builtin_amdgcn_logf(gamma);
    const float cdecay = __builtin_amdgcn_exp2f(128.0f * lg);
    f32x4 kvacc[8];
#pragma unroll
    for (int d = 0; d < 8; ++d) kvacc[d] = (f32x4){0.f, 0.f, 0.f, 0.f};
    v4u pk_[4], pv_[4]; bf16x8 qn[4];
    {
        const int tid = F.tid, lane = tid & 63, col = lane & 15, q = lane >> 4; const size_t row0 = (size_t)b * SEQ;
#pragma unroll
        for (int i = 0; i < 4; ++i) { const int piece = tid + 512 * i, m = piece >> 4, d8 = piece & 15;
            pk_[i] = *(const v4u*)(P + (row0 + m) * DIN + 1536 + 128 * hh + 8 * d8); pv_[i] = *(const v4u*)(P + (row0 + m) * DIN + 2048 + 128 * hh + 8 * d8); }
#pragma unroll
        for (int s = 0; s < 4; ++s) qn[s] = *(const bf16x8*)(P + (row0 + 16 * F.wave + col) * DIN + 1024 + 128 * hh + 32 * s + 8 * q);
    }
    for (int n = 0; n < NCHUNK; ++n) {
        int tid = F.tid, w = F.wave; asm volatile("" : "+v"(tid)); asm volatile("" : "+s"(w));
        const int lane = tid & 63, col = lane & 15, q = lane >> 4;
        const size_t row0 = (size_t)b * SEQ + (size_t)n * CHUNK;
        LDS_BARRIER();
#pragma unroll
        for (int i = 0; i < 4; ++i) { const int piece = tid + 512 * i, m = piece >> 4, d8 = piece & 15;
            *(LAS v4u*)(lds + R2_KI + (m * RS2 + 8 * d8) * 2) = pk_[i]; *(LAS v4u*)(lds + R2_VI + (m * RS2 + 8 * d8) * 2) = pv_[i]; }
#pragma unroll
        for (int db = 0; db < 8; ++db) { v2u pw; pw.x = pk2(kvacc[db][0], kvacc[db][1]); pw.y = pk2(kvacc[db][2], kvacc[db][3]);
            *(LAS v2u*)(lds + R2_PT + ((16 * w + col) * RS2 + 16 * db + 4 * q) * 2) = pw; }
        bf16x8 qf[4];
#pragma unroll
        for (int s = 0; s < 4; ++s) qf[s] = qn[s];
        LDS_BARRIER();
        if (n + 1 < NCHUNK) {
            const size_t rown = row0 + CHUNK;
#pragma unroll
            for (int i = 0; i < 4; ++i) { const int piece = tid + 512 * i, m = piece >> 4, d8 = piece & 15;
                pk_[i] = *(const v4u*)(P + (rown + m) * DIN + 1536 + 128 * hh + 8 * d8); pv_[i] = *(const v4u*)(P + (rown + m) * DIN + 2048 + 128 * hh + 8 * d8); }
#pragma unroll
            for (int s = 0; s < 4; ++s) qn[s] = *(const bf16x8*)(P + (rown + 16 * w + col) * DIN + 1024 + 128 * hh + 32 * s + 8 * q);
        }
        v2u gpre[8];
#pragma unroll
        for (int eb = 0; eb < 8; ++eb) gpre[eb] = *(const v2u*)(P + (row0 + 16 * w + col) * DIN + 2560 + 128 * hh + 16 * eb + 4 * q);
        f32x4 out[8];
#pragma unroll
        for (int eb = 0; eb < 8; ++eb) { f32x4 c4 = (f32x4){0.f, 0.f, 0.f, 0.f};
#pragma unroll
            for (int s = 0; s < 4; ++s) { const bf16x8 pf = *(const LAS bf16x8*)(lds + R2_PT + ((16 * eb + col) * RS2 + 32 * s + 8 * q) * 2);
                c4 = __builtin_amdgcn_mfma_f32_16x16x32_bf16(pf, qf[s], c4, 0, 0, 0); }
            out[eb] = c4; }
        {
            const float xi = __builtin_amdgcn_exp2f((float)(16 * w + col + 1) * lg);
#pragma unroll
            for (int eb = 0; eb < 8; ++eb) out[eb] = out[eb] * xi;
        }
        LAS unsigned char* trV = lds + R2_VI + ((col >> 2) * RS2 + 4 * (col & 3)) * 2;
        LAS unsigned char* trK = lds + R2_KI + ((col >> 2) * RS2 + 4 * (col & 3)) * 2;
#pragma unroll
        for (int t = 0; t < 4; ++t) {
            if (2 * t <= w) {
                f32x4 sa = (f32x4){0.f, 0.f, 0.f, 0.f}, sb = (f32x4){0.f, 0.f, 0.f, 0.f};
#pragma unroll
                for (int s = 0; s < 4; ++s) {
                    const bf16x8 ka = *(const LAS bf16x8*)(lds + R2_KI + ((32 * t + col) * RS2 + 32 * s + 8 * q) * 2);
                    const bf16x8 kb = *(const LAS bf16x8*)(lds + R2_KI + ((32 * t + 16 + col) * RS2 + 32 * s + 8 * q) * 2);
                    sa = __builtin_amdgcn_mfma_f32_16x16x32_bf16(ka, qf[s], sa, 0, 0, 0);
                    sb = __builtin_amdgcn_mfma_f32_16x16x32_bf16(kb, qf[s], sb, 0, 0, 0);
                }
                const int c = 16 * w + col;
                float va[4], vb[4];
#pragma unroll
                for (int r = 0; r < 4; ++r) { const int ma = 32 * t + 4 * q + r, mb = ma + 16;
                    va[r] = (c >= ma) ? sa[r] * __builtin_amdgcn_exp2f((float)(c - ma) * lg) : 0.f;
                    vb[r] = (c >= mb) ? sb[r] * __builtin_amdgcn_exp2f((float)(c - mb) * lg) : 0.f; }
                v4u sw; sw.x = pk2(va[0], va[1]); sw.y = pk2(va[2], va[3]); sw.z = pk2(vb[0], vb[1]); sw.w = pk2(vb[2], vb[3]);
                const bf16x8 sfr = __builtin_bit_cast(bf16x8, sw);
#pragma unroll
                for (int eb = 0; eb < 8; ++eb) {
                    const bf16x8 vf = tr_pair(trV + ((32 * t + 4 * q) * RS2 + 16 * eb) * 2, trV + ((32 * t + 16 + 4 * q) * RS2 + 16 * eb) * 2);
                    out[eb] = __builtin_amdgcn_mfma_f32_16x16x32_bf16(vf, sfr, out[eb], 0, 0, 0);
                }
            }
        }
        {
            float sq = 0.f;
#pragma unroll
            for (int eb = 0; eb < 8; ++eb) sq += (out[eb][0] * out[eb][0] + out[eb][1] * out[eb][1]) + (out[eb][2] * out[eb][2] + out[eb][3] * out[eb][3]);
            sq += __shfl_xor(sq, 16); sq += __shfl_xor(sq, 32);
            const float rs = rsqrtf(sq * (1.0f / DH) + EPS);
            const size_t row = row0 + 16 * w + col;
#pragma unroll
            for (int eb = 0; eb < 8; ++eb) {
                const v2u gw2 = gpre[eb];
                v2u o; o.x = pk2(out[eb][0] * rs * bflo(gw2.x), out[eb][1] * rs * bfhi(gw2.x)); o.y = pk2(out[eb][2] * rs * bflo(gw2.y), out[eb][3] * rs * bfhi(gw2.y));
                *(v2u*)(Y + row * DM + DRNN + 128 * hh + 16 * eb + 4 * q) = o;
            }
        }
        {
            bf16x8 vfz[4];
#pragma unroll
            for (int t = 0; t < 4; ++t) {
                const bf16x8 vraw = tr_pair(trV + ((32 * t + 8 * q) * RS2 + 16 * w) * 2, trV + ((32 * t + 8 * q + 4) * RS2 + 16 * w) * 2);
                const v4u vw = __builtin_bit_cast(v4u, vraw); v4u zw;
                const float mb = (float)(127 - 32 * t - 8 * q);
                zw.x = pk2(bflo(vw.x) * __builtin_amdgcn_exp2f((mb - 0.f) * lg), bfhi(vw.x) * __builtin_amdgcn_exp2f((mb - 1.f) * lg));
                zw.y = pk2(bflo(vw.y) * __builtin_amdgcn_exp2f((mb - 2.f) * lg), bfhi(vw.y) * __builtin_amdgcn_exp2f((mb - 3.f) * lg));
                zw.z = pk2(bflo(vw.z) * __builtin_amdgcn_exp2f((mb - 4.f) * lg), bfhi(vw.z) * __builtin_amdgcn_exp2f((mb - 5.f) * lg));
                zw.w = pk2(bflo(vw.w) * __builtin_amdgcn_exp2f((mb - 6.f) * lg), bfhi(vw.w) * __builtin_amdgcn_exp2f((mb - 7.f) * lg));
                vfz[t] = __builtin_bit_cast(bf16x8, zw);
            }
#pragma unroll
            for (int db = 0; db < 8; ++db) { f32x4 c4 = kvacc[db] * cdecay;
#pragma unroll
                for (int t = 0; t < 4; ++t) { const bf16x8 kf = tr_pair(trK + ((32 * t + 8 * q) * RS2 + 16 * db) * 2, trK + ((32 * t + 8 * q + 4) * RS2 + 16 * db) * 2);
                    c4 = __builtin_amdgcn_mfma_f32_16x16x32_bf16(kf, vfz[t], c4, 0, 0, 0); }
                kvacc[db] = c4; }
        }
    }
}

__global__ void __launch_bounds__(NWAVES * 64, 2) hymba_fwd(Args args) {
    extern __shared__ __attribute__((aligned(16))) unsigned char lds_raw[];
    Frame F;
    F.lds = (LAS unsigned char*)lds_raw;
    F.tid = threadIdx.x; F.lane = F.tid & 63; F.wave = __builtin_amdgcn_readfirstlane(F.tid >> 6); F.G = gridDim.x;
    unsigned char* ws = KA::ws();
    const int lo = KA::lo(), hi = KA::hi();
    if (F.tid < 16) ((LAS unsigned*)(F.lds + MISC_OFF))[F.tid] = 0u;
    __syncthreads();
    XcdBarrier bar; bar.bar = (unsigned*)(ws + WS_CTL) + CW_BAR; bar.x = 0; bar.st = nullptr;
    if (hi - lo > 1) bar = xcd_barrier_post((unsigned*)(ws + WS_CTL) + CW_BAR, (volatile LAS unsigned*)(F.lds + MISC_OFF));
#define IN(k) (lo <= (k) && (k) < hi)
#define SEAM(k) do { if (IN(k) && IN((k) + 1)) xcd_barrier(bar); } while (0)

    bf16* XB = (bf16*)(ws + WS_XB); float* SS = (float*)(ws + WS_SS); bf16* YB = (bf16*)(ws + WS_Y); bf16* PH = (bf16*)(ws + WS_PH);

#ifndef SK_PREP
    if (IN(0)) { phase_prep(F, args); }
#endif

    SEAM(0);
    for (int sb = 0; sb < 3 * DEPTH; ++sb) {
        const int l = sb / 3, t = sb % 3; const int p0 = 1 + 7 * l + (t == 0 ? 0 : (t == 1 ? 2 : 5));
        unsigned char* wl = ws + WS_W + (size_t)l * SZ_WLAYER;
        if (t != 1) {
#ifndef SK_FFNIN
            if (IN(p0)) {
                pg8::Gemm g{XB, (const bf16*)(wl + (t == 0 ? OFF_W1IN : OFF_W2IN)), MTOK, NFF, DM}; pg8::StaticOrder S; S.init(MTOK, NFF, F.G, (int)blockIdx.x);
                EpiSwiGLU E{PH, SS};
                pg8::gemm_phase<EpiSwiGLU, pg8::StaticOrder, PG8_ALIGN, PG8_SP2>(F.lds, g, S, E);
            }
#endif

            SEAM(p0);
#ifndef SK_FFNOUT
            if (IN(p0 + 1)) {
                pg8::Gemm g{PH, (const bf16*)(wl + (t == 0 ? OFF_W1OUT : OFF_W2OUT)), MTOK, DM, DFF}; pg8::StaticOrder S; S.init(MTOK, DM, F.G, (int)blockIdx.x);
                EpiResid E{(sb == 0) ? (const float*)KA::in(0) : (const float*)nullptr, XB, SS, KA::dry() ? 0.f : 0.5f};
                pg8::gemm_phase<EpiResid, pg8::StaticOrder, PG8_ALIGN, PG8_SP2>(F.lds, g, S, E);
            }
#endif

            SEAM(p0 + 1);
        } else {
#ifndef SK_PROJ
            if (IN(p0)) {
                pg8::Gemm g{XB, (const bf16*)(wl + OFF_WIN), MTOK, DIN, DM}; pg8::StaticOrder S; S.init(MTOK, DIN, F.G, (int)blockIdx.x);
                EpiProj E{PH, SS, (const int*)KA::in(1)};
                pg8::gemm_phase<EpiProj, pg8::StaticOrder, PG8_ALIGN, PG8_SP2>(F.lds, g, S, E);
            }
#endif

            SEAM(p0);
            if (IN(p0 + 1)) {
#ifndef SK_LRU
                for (int rep = 0; rep < REP_LRU; ++rep)
                for (int u = blockIdx.x; u < BATCH * NRB; u += F.G) lru_unit(F, args, l, u / NRB, u % NRB);
#endif

#ifndef SK_RET
#if RET_V2
                for (int rep = 0; rep < REP_RET; ++rep)
                for (int u = blockIdx.x; u < BATCH * NHEAD; u += F.G) ret_unit2(F, args, u / NHEAD, u % NHEAD);
#else
                for (int u = blockIdx.x; u < BATCH * NHEAD; u += F.G) ret_unit(F, args, u / NHEAD, u % NHEAD);
#endif
#endif

            }
            SEAM(p0 + 1);
#ifndef SK_WOUT
            if (IN(p0 + 2)) {
                pg8::Gemm g{YB, (const bf16*)(wl + OFF_WOUT), MTOK, DM, DM}; pg8::StaticOrder S; S.init(MTOK, DM, F.G, (int)blockIdx.x);
                EpiResid E{(const float*)nullptr, XB, SS, KA::dry() ? 0.f : 1.0f};
                pg8::gemm_phase<EpiResid, pg8::StaticOrder, PG8_ALIGN, PG8_SP2>(F.lds, g, S, E);
            }
#endif

            SEAM(p0 + 2);
        }
    }
#ifndef SK_FINAL
    if (IN(1 + 7 * DEPTH)) phase_final(F, args);
#endif

#undef IN
#undef SEAM
}

extern "C" void kernel_launch(void* const* d_in, const int* in_sizes, int n_in, void* d_out, int out_size, void* d_ws, size_t ws_size, hipStream_t stream) {
    static int grid = 0;
    if (grid == 0) {
        if (n_in != 19 || in_sizes[0] != MTOK * DM || out_size != MTOK * DM || ws_size < WS_END) {
            fprintf(stderr, "kernel_launch: unexpected shapes (n_in %d, in0 %d, out %d, ws %zu); nothing launched\n", n_in, n_in > 0 ? in_sizes[0] : -1, out_size, ws_size); grid = -1; return; }
        int dev = 0, cus = 0, per_cu = 0;
        if (hipGetDevice(&dev) != hipSuccess || hipDeviceGetAttribute(&cus, hipDeviceAttributeMultiprocessorCount, dev) != hipSuccess) { grid = -1; return; }
        if (hipFuncSetAttribute((const void*)hymba_fwd, hipFuncAttributeMaxDynamicSharedMemorySize, LDS_BYTES) != hipSuccess) { fprintf(stderr, "kernel_launch: hipFuncSetAttribute failed\n"); grid = -1; return; }
        if (hipOccupancyMaxActiveBlocksPerMultiprocessor(&per_cu, (const void*)hymba_fwd, NWAVES * 64, LDS_BYTES) != hipSuccess || per_cu < 1)
            fprintf(stderr, "kernel_launch: note: occupancy query reports %d workgroups per CU\n", per_cu);
        (void)hipGetLastError();
        grid = cus;
    }
    if (grid < 0) return;
    (void)hipMemsetAsync((char*)d_ws + WS_CTL, 0, CTL_ZERO_BYTES, stream);
    Args a{};
    for (int i = 0; i < 19; ++i) a.in[i] = d_in[i];
    a.out = (float*)d_out; a.ws = (unsigned char*)d_ws;
    constexpr int NPH = 2 + 7 * DEPTH;
#if PROBE_REP_PHASE >= 0
    for (int p = 0; p < NPH; ++p) for (int rep = 0; rep < (p == PROBE_REP_PHASE ? 2 : 1); ++rep) { a.ph_lo = p; a.ph_hi = p + 1; a.dry = (p == PROBE_REP_PHASE && rep == 0) ? 1 : 0; hipLaunchKernelGGL(hymba_fwd, dim3(grid), dim3(NWAVES * 64), LDS_BYTES, stream, a); }
#elif MK_PER_PHASE
    for (int p = 0; p < NPH; ++p) { a.ph_lo = p; a.ph_hi = p + 1; hipLaunchKernelGGL(hymba_fwd, dim3(grid), dim3(NWAVES * 64), LDS_BYTES, stream, a); }
#else
    a.ph_lo = 0; a.ph_hi = NPH; hipLaunchKernelGGL(hymba_fwd, dim3(grid), dim3(NWAVES * 64), LDS_BYTES, stream, a);
#endif
}
```

```cpp
#include <hip/hip_runtime.h>
#include <cstdio>
#include <cstdint>

#define PROBE_TMASK 0
#define FFNOUT_REV 1
#define RELAX_STORE_WAIT 1
#define PROBE_ST 0
#define WEIGHTS_BLOCKED 1
#define REP_EPI 1
#define REP_LRU 1
#define REP_RET 1
#define LRU_V 3
#define RET_V 3
#define RET_V2 1
#define PROBE_REP_PHASE -1
#ifndef MK_PER_PHASE
#define MK_PER_PHASE 0
#endif

__device__ __forceinline__ float shx(float v, int o, int lane) { return __builtin_bit_cast(float, __builtin_amdgcn_ds_bpermute((lane ^ o) << 2, __builtin_bit_cast(int, v))); }
__device__ __forceinline__ int hw_lane() { int l; asm volatile("v_mbcnt_lo_u32_b32 %0, -1, 0\n\tv_mbcnt_hi_u32_b32 %0, -1, %0" : "=v"(l)); return l; }
namespace pg8 {
#define PG8_LAS __attribute__((address_space(3)))
typedef unsigned short bf16_t;
typedef short bf16x8 __attribute__((ext_vector_type(8)));
typedef float f32x4 __attribute__((ext_vector_type(4)));
typedef unsigned u32x4 __attribute__((ext_vector_type(4)));
constexpr int BM = 256, BK = 64, HALF = 128, HTB = HALF * BK * 2, STAGE_BYTES = 8 * HTB, NXCD = 8, WGM = 8;

__host__ __device__ __forceinline__ int lds_byte(int r, int c) { const int st = (r >> 4) * 2 + (c >> 5), rr = r & 15, cc = c & 31, ob = rr * 64 + cc * 2; return st * 1024 + (ob ^ (((ob >> 9) & 1) << 5)); }
__host__ __device__ __forceinline__ void stage_rc(int b, int& R, int& C) { const int st = b / 1024, sb = b % 1024, swz = sb ^ (((sb >> 9) & 1) << 5); R = (st >> 1) * 16 + swz / 64; C = (st & 1) * 32 + (swz % 64) / 2; }
__host__ __device__ __forceinline__ int perm32(int rho) { const int n = rho >> 4, i = rho & 15; return 8 * (i >> 2) + 4 * n + (i & 3); }

struct Unit { int pm, pn; };
struct Gemm { const bf16_t* A; const bf16_t* Bt; int M, N, K; };

struct StaticOrder {
    int nM, nN, nwg, G, c, rev;
    __host__ __device__ void init(int M, int N, int G_, int c_, int rev_ = 0) { nM = M / BM; nN = N / BM; nwg = nM * nN; G = G_; c = c_; rev = rev_; }
    __host__ __device__ bool next(int i, Unit& u) const {
        const int rounds = (nwg + G - 1) / G; if (i >= rounds) return false;
        const long L = (long)(rev ? rounds - 1 - i : i) * G + c; if (L >= nwg) return false;
        int wgid = (int)L; { const int q = nwg / NXCD, r = nwg % NXCD, xcd = wgid % NXCD, off = wgid / NXCD; wgid = (xcd < r ? xcd * (q + 1) : r * (q + 1) + (xcd - r) * q) + off; }
        const int nig = WGM * nN, gid = wgid / nig, fm = gid * WGM, gsz = (nM - fm) < WGM ? (nM - fm) : WGM;
        u.pm = fm + ((wgid % nig) % gsz); u.pn = (wgid % nig) / gsz; return true;
    }
    __device__ __forceinline__ void a_ready(const Unit&) const {}
    __device__ __forceinline__ void done(const Unit&) const {}
};

__device__ __forceinline__ unsigned cvt_pk_bf16(float lo, float hi) { unsigned r; asm("v_cvt_pk_bf16_f32 %0, %1, %2" : "=v"(r) : "v"(lo), "v"(hi)); return r; }

template <class Epi, class Sched, bool ALIGN_EPI = false, bool SP2 = false, bool ABLK = false, bool ALIN = false>
__device__ __forceinline__ void gemm_phase(PG8_LAS unsigned char* lds, const Gemm g, const Sched& S, const Epi& E, int wave) {
    int tid = wave * 64 + hw_lane(); asm volatile("" : "+v"(tid));
    const int wid = __builtin_amdgcn_readfirstlane(tid >> 6), lane = tid & 63, wr = wid >> 2, wc = wid & 3, fr = lane & 15, fq = lane >> 4;
    const int K = g.K, nt = K / BK;
    constexpr bool BBLK_ = Epi::PERM && WEIGHTS_BLOCKED;
    unsigned voffA[2], voffB[2];
#pragma unroll
    for (int i = 0; i < 2; ++i) { int R, C; stage_rc(tid * 16 + i * 8192, R, C); const int Rb = Epi::PERM ? ((R & ~31) + perm32(R & 31)) : R;
        voffA[i] = ALIN ? (unsigned)((((tid >> 6) + 8 * i) & 1) * 16384 + (((tid >> 6) + 8 * i) >> 1) * 1024 + (tid & 63) * 16) : ABLK ? (unsigned)((C >> 5) * 16384 + R * 64 + (C & 31) * 2) : (unsigned)(R * K + C) * 2u; voffB[i] = BBLK_ ? (unsigned)((C >> 5) * 16384 + R * 64 + (C & 31) * 2) : (unsigned)(Rb * K + C) * 2u; }
    const size_t kstep = (size_t)(BK * 2);
    const size_t hstep = (size_t)HALF * K * 2;
    const size_t tstep = 2 * hstep;
    const size_t kstepB = BBLK_ ? (size_t)32768 : kstep, hstepB = BBLK_ ? (size_t)8192 : hstep;
    const size_t kstepA = ABLK ? (size_t)32768 : kstep, hstepA = ABLK ? (size_t)8192 : hstep;
    const unsigned ldsw = (unsigned)wid * 1024u;
    const int aoff = ALIN ? wr * 8192 + lane * 16 : lds_byte(wr * 64 + fr, fq * 8), boff = lds_byte(wc * 32 + fr, fq * 8);
#define PG8_SA(b, h) (((b) * 2 + (h)) * HTB)
#define PG8_SB(b, h) ((4 + (b) * 2 + (h)) * HTB)
#define PG8_STAGE(bufoff, gbase, voff) do { _Pragma("unroll") for (int _i = 0; _i < 2; ++_i) \
        __builtin_amdgcn_global_load_lds((const unsigned*)((const char*)(gbase) + (voff)[_i]), (PG8_LAS unsigned*)(lds + (bufoff) + ldsw + _i * 8192), 16, 0, 0); } while (0)
#define PG8_LDA(dst, b, h) do { _Pragma("unroll") for (int m = 0; m < 4; ++m) _Pragma("unroll") for (int k = 0; k < 2; ++k) dst[m][k] = *(const PG8_LAS bf16x8*)(lds + PG8_SA(b, h) + aoff + m * 2048 + k * 1024); } while (0)
#define PG8_LDB(dst, b, h) do { _Pragma("unroll") for (int n = 0; n < 2; ++n) _Pragma("unroll") for (int k = 0; k < 2; ++k) dst[n][k] = *(const PG8_LAS bf16x8*)(lds + PG8_SB(b, h) + boff + n * 2048 + k * 1024); } while (0)
#define PG8_MMA(ai, bj, At, Bt) do { __builtin_amdgcn_s_setprio(1); _Pragma("unroll") for (int m = 0; m < 4; ++m) _Pragma("unroll") for (int n = 0; n < 2; ++n) _Pragma("unroll") for (int k = 0; k < 2; ++k) \
        acc[ai][bj][m][n] = __builtin_amdgcn_mfma_f32_16x16x32_bf16(Bt[n][k], At[m][k], acc[ai][bj][m][n], 0, 0, 0); __builtin_amdgcn_s_setprio(0); } while (0)
#define PG8_WAIT_V(n) asm volatile("s_waitcnt vmcnt(" #n ")" ::: "memory")
#define PG8_WAIT_L(n) asm volatile("s_waitcnt lgkmcnt(" #n ")" ::: "memory")
#define PG8_WAIT_V8R(rx) asm volatile("s_cmp_eq_u32 %0, 0\n\ts_cbranch_scc0 .Lrw%=\n\ts_waitcnt vmcnt(8)\n.Lrw%=:\n\ts_waitcnt vmcnt(%1)" :: "s"(rx), "n"(8 + Epi::NSTORES) : "memory", "scc")
#define PG8_BAR __builtin_amdgcn_s_barrier()
#define PG8_SCHED __builtin_amdgcn_sched_barrier(0)
    Unit cur, nxt; int ui = 0;
    if (!S.next(0, cur)) return;
    f32x4 acc[2][2][4][2];
#pragma unroll
    for (int a = 0; a < 2; ++a)
#pragma unroll
        for (int b = 0; b < 2; ++b)
#pragma unroll
            for (int m = 0; m < 4; ++m)
#pragma unroll
                for (int n = 0; n < 2; ++n) acc[a][b][m][n] = (f32x4){0.f, 0.f, 0.f, 0.f};
    bf16x8 At[4][2], B0[2][2], B1[2][2];
    const char* cA = (const char*)g.A + (size_t)cur.pm * tstep; const char* cB = (const char*)g.Bt + (size_t)cur.pn * tstep;
    S.a_ready(cur);
    if constexpr (SP2) {
        PG8_STAGE(PG8_SB(0, 0), cB, voffB); PG8_STAGE(PG8_SB(0, 1), cB + hstepB, voffB); PG8_STAGE(PG8_SA(0, 0), cA, voffA); PG8_STAGE(PG8_SA(0, 1), cA + hstepA, voffA);
        if (wr == 1) PG8_BAR;
        PG8_WAIT_V(2); PG8_BAR;
        PG8_STAGE(PG8_SB(1, 0), cB + kstepB, voffB); PG8_STAGE(PG8_SA(1, 0), cA + kstepA, voffA); PG8_STAGE(PG8_SB(1, 1), cB + hstepB + kstepB, voffB);
        PG8_WAIT_V(6); PG8_BAR;
    } else {
        PG8_STAGE(PG8_SB(0, 0), cB, voffB); PG8_STAGE(PG8_SA(0, 0), cA, voffA); PG8_STAGE(PG8_SB(0, 1), cB + hstepB, voffB); PG8_STAGE(PG8_SA(0, 1), cA + hstepA, voffA);
        if (wr == 1) PG8_BAR;
        PG8_WAIT_V(4); PG8_BAR;
        PG8_STAGE(PG8_SB(1, 0), cB + kstepB, voffB); PG8_STAGE(PG8_SA(1, 0), cA + kstepA, voffA); PG8_STAGE(PG8_SB(1, 1), cB + hstepB + kstepB, voffB);
        PG8_WAIT_V(6); PG8_BAR;
    }
    for (;;) {
        const bool has_next = S.next(ui + 1, nxt);
        const char* nA = has_next ? (const char*)g.A + (size_t)nxt.pm * tstep : cA; const char* nB = has_next ? (const char*)g.Bt + (size_t)nxt.pn * tstep : cB;
        for (int t = 0; t < nt; t += 2) {
            const bool last = (t == nt - 2);
            const int relax = __builtin_amdgcn_readfirstlane((RELAX_STORE_WAIT && t == 0 && ui > 0) ? 1 : 0);
            const char* a1 = cA + (size_t)(t + 1) * kstepA;
            const char* a2 = last ? nA : cA + (size_t)(t + 2) * kstepA; const char* b2 = last ? nB : cB + (size_t)(t + 2) * kstepB;
            const char* a3 = a2 + kstepA; const char* b3 = b2 + kstepB;
            if (last && has_next) S.a_ready(nxt);
            if constexpr (SP2) {
            PG8_LDB(B0, 0, 0); PG8_LDB(B1, 0, 1); PG8_SCHED; PG8_LDA(At, 0, 0); PG8_STAGE(PG8_SA(1, 1), a1 + hstepA, voffA);
            PG8_WAIT_V8R(relax); PG8_WAIT_L(0); PG8_BAR; PG8_MMA(0, 0, At, B0); PG8_MMA(0, 1, At, B1); PG8_BAR; PG8_SCHED;
            PG8_LDA(At, 0, 1); PG8_STAGE(PG8_SB(0, 0), b2, voffB); PG8_STAGE(PG8_SB(0, 1), b2 + hstepB, voffB); PG8_STAGE(PG8_SA(0, 0), a2, voffA);
            PG8_WAIT_V8R(relax); PG8_WAIT_L(0); PG8_BAR; PG8_MMA(1, 0, At, B0); PG8_MMA(1, 1, At, B1); PG8_BAR; PG8_SCHED;
            PG8_LDB(B0, 1, 0); PG8_LDB(B1, 1, 1); PG8_SCHED; PG8_LDA(At, 1, 0); PG8_STAGE(PG8_SA(0, 1), a2 + hstepA, voffA);
            PG8_WAIT_V(8); PG8_WAIT_L(0); PG8_BAR; PG8_MMA(0, 0, At, B0); PG8_MMA(0, 1, At, B1); PG8_BAR; PG8_SCHED;
            PG8_LDA(At, 1, 1); PG8_STAGE(PG8_SB(1, 0), b3, voffB); PG8_STAGE(PG8_SB(1, 1), b3 + hstepB, voffB); PG8_STAGE(PG8_SA(1, 0), a3, voffA);
            PG8_WAIT_V(8); PG8_WAIT_L(0); PG8_BAR; PG8_MMA(1, 0, At, B0); PG8_MMA(1, 1, At, B1); PG8_BAR; PG8_SCHED;
            } else {
            PG8_LDB(B0, 0, 0); PG8_SCHED; PG8_LDA(At, 0, 0); PG8_STAGE(PG8_SA(1, 1), a1 + hstepA, voffA);
            PG8_WAIT_L(8); PG8_BAR; PG8_WAIT_L(0); PG8_MMA(0, 0, At, B0); PG8_BAR; PG8_SCHED;
            PG8_LDB(B1, 0, 1); PG8_STAGE(PG8_SB(0, 0), b2, voffB);
            PG8_BAR; PG8_WAIT_L(0); PG8_MMA(0, 1, At, B1); PG8_BAR;
            PG8_LDA(At, 0, 1); PG8_STAGE(PG8_SA(0, 0), a2, voffA);
            PG8_BAR; PG8_WAIT_L(0); PG8_MMA(1, 0, At, B0); PG8_BAR; PG8_SCHED;
            PG8_STAGE(PG8_SB(0, 1), b2 + hstepB, voffB);
            PG8_WAIT_V(6); PG8_BAR; PG8_MMA(1, 1, At, B1); PG8_BAR;
            PG8_LDB(B0, 1, 0); PG8_SCHED; PG8_LDA(At, 1, 0); PG8_STAGE(PG8_SA(0, 1), a2 + hstepA, voffA);
            PG8_WAIT_L(8); PG8_BAR; PG8_WAIT_L(0); PG8_MMA(0, 0, At, B0); PG8_BAR; PG8_SCHED;
            PG8_LDB(B1, 1, 1); PG8_STAGE(PG8_SB(1, 0), b3, voffB);
            PG8_BAR; PG8_WAIT_L(0); PG8_MMA(0, 1, At, B1); PG8_BAR;
            PG8_LDA(At, 1, 1); PG8_STAGE(PG8_SA(1, 0), a3, voffA);
            PG8_BAR; PG8_WAIT_L(0); PG8_MMA(1, 0, At, B0); PG8_BAR; PG8_SCHED;
            PG8_STAGE(PG8_SB(1, 1), b3 + hstepB, voffB);
            PG8_WAIT_V(6); PG8_BAR; PG8_MMA(1, 1, At, B1); PG8_BAR;
            }
        }
        if constexpr (ALIGN_EPI) { if (wr == 0) PG8_BAR; }
        static_assert(ALIGN_EPI, "the epilogues' prep() barrier needs both half-workgroups aligned");
        E.prep(cur, lds, tid);
        E(acc, cur, wr, wc, fr, fq);
#if REP_EPI > 1
        if constexpr (Epi::IDEMP) { for (int rep = 1; rep < REP_EPI; ++rep) { asm volatile("" ::: "memory"); E(acc, cur, wr, wc, fr, fq); } }
#endif
        S.done(cur);
        if (!has_next) break;
        {
            float zf = 0.f;
#pragma unroll
            for (int a = 0; a < 2; ++a)
#pragma unroll
                for (int b = 0; b < 2; ++b)
#pragma unroll
                    for (int m = 0; m < 4; ++m)
#pragma unroll
                        for (int n = 0; n < 2; ++n) { asm volatile("" : "+v"(zf)); acc[a][b][m][n] = __builtin_amdgcn_mfma_f32_4x4x1f32(zf, zf, (f32x4){0.f, 0.f, 0.f, 0.f}, 0, 0, 0); }
        }
        cur = nxt; cA = nA; cB = nB; ++ui;
        if constexpr (ALIGN_EPI) { if (wr == 1) PG8_BAR; }
    }
    PG8_WAIT_V(0);
    if constexpr (!ALIGN_EPI) { if (wr == 0) PG8_BAR; }
    PG8_BAR;
#undef PG8_SA
#undef PG8_SB
#undef PG8_STAGE
#undef PG8_LDA
#undef PG8_LDB
#undef PG8_MMA
#undef PG8_WAIT_V
#undef PG8_WAIT_V8R
#undef PG8_WAIT_L
#undef PG8_BAR
#undef PG8_SCHED
}
}

#define PG8_SP2 true
#define PG8_ALIGN true

constexpr int NWAVES = 8;
constexpr int BATCH = 32, SEQ = 2048, DM = 1024, MTOK = BATCH * SEQ, DFF = 2816, NFF = 2 * DFF, DIN = 3072;
constexpr int DRNN = 512, NRB = 8, RB = 64, NHEAD = 4, DH = 128, CHUNK = 128, NCHUNK = SEQ / CHUNK, DEPTH = 2;
constexpr float EPS = 1e-6f;

constexpr size_t MiB = 1u << 20;
constexpr size_t WS_CTL = 0, CTL_ZERO_BYTES = 32768;
constexpr size_t SZ_WFIN = (size_t)NFF * DM * 2, SZ_WFOUT = (size_t)DM * DFF * 2, SZ_WIN = (size_t)DIN * DM * 2, SZ_WOUT = (size_t)DM * DM * 2;
constexpr size_t OFF_W1IN = 0, OFF_W1OUT = OFF_W1IN + SZ_WFIN, OFF_WIN = OFF_W1OUT + SZ_WFOUT, OFF_WOUT = OFF_WIN + SZ_WIN, OFF_W2IN = OFF_WOUT + SZ_WOUT, OFF_W2OUT = OFF_W2IN + SZ_WFIN;
constexpr size_t SZ_WLAYER = OFF_W2OUT + SZ_WFOUT;
constexpr size_t WS_W = 2 * MiB;
constexpr size_t WS_XB = 96 * MiB;
constexpr size_t WS_SS = 224 * MiB;
constexpr size_t WS_Y = 232 * MiB;
constexpr size_t WS_PH = 360 * MiB;
constexpr size_t WS_END = 744 * MiB;
static_assert(WS_W + 2 * SZ_WLAYER <= WS_XB, "weights fit");
constexpr int CW_BAR = 4096;
static_assert((CW_BAR + 3456) * 4 <= (int)CTL_ZERO_BYTES, "barrier words inside the per-call memset");

constexpr int LDS_BYTES = 147456;
constexpr int MISC_OFF = LDS_BYTES - 64;

#define LAS __attribute__((address_space(3)))
typedef unsigned short bf16;
typedef unsigned v4u __attribute__((ext_vector_type(4)));
typedef unsigned v2u __attribute__((ext_vector_type(2)));
typedef float f32x4 __attribute__((ext_vector_type(4)));
typedef short bf16x8 __attribute__((ext_vector_type(8)));
typedef short bf16x4 __attribute__((ext_vector_type(4)));
#define LDS_WAIT() asm volatile("s_waitcnt lgkmcnt(0)" ::: "memory")
#define VM_WAIT() asm volatile("s_waitcnt vmcnt(0)" ::: "memory")
#define LDS_BARRIER() do { asm volatile("s_waitcnt lgkmcnt(0)" ::: "memory"); __builtin_amdgcn_s_barrier(); asm volatile("" ::: "memory"); } while (0)
__device__ __forceinline__ unsigned pk2(float lo, float hi) { unsigned r; asm("v_cvt_pk_bf16_f32 %0, %1, %2" : "=v"(r) : "v"(lo), "v"(hi)); return r; }
__device__ __forceinline__ unsigned f2bf(float f) { return pk2(f, 0.f) & 0xffffu; }
__device__ __forceinline__ float bf2f(unsigned b) { return __builtin_bit_cast(float, b << 16); }
__device__ __forceinline__ float bflo(unsigned w) { return __builtin_bit_cast(float, w << 16); }
__device__ __forceinline__ float bfhi(unsigned w) { return __builtin_bit_cast(float, w & 0xffff0000u); }

#define XB_TMO      128
#define XB_XCNT(j)  (256  + 64 * (j))
#define XB_XSUB(j)  (1280 + 64 * (j))
#define XB_XGEN(j)  (2304 + 64 * (j))
#define XB_TOP      3328
#define XB_TOPGEN   3392
#define XCD_BAR_WORDS 3456
#define XB_SPIN_CAP (1u << 18)

#define GAS __attribute__((address_space(1)))
typedef GAS unsigned gu32;
__device__ __forceinline__ unsigned xb_ld(gu32* p)              { return __hip_atomic_load(p, __ATOMIC_RELAXED, __HIP_MEMORY_SCOPE_AGENT); }
__device__ __forceinline__ unsigned xb_add(gu32* p, unsigned v) { return __hip_atomic_fetch_add(p, v, __ATOMIC_RELAXED, __HIP_MEMORY_SCOPE_AGENT); }
__device__ __forceinline__ unsigned xb_xcc_id() { return (unsigned)__builtin_amdgcn_s_getreg((3 << 11) | 20) & 0xFu; }
#define XB_SPIN(cond, bar) do { unsigned _sp = 0; while (cond) { __builtin_amdgcn_s_sleep(1); \
    if ((++_sp & 255u) == 0u) { if (xb_ld(&(bar)[XB_TMO])) break; if (_sp > XB_SPIN_CAP) { xb_add(&(bar)[XB_TMO], 1u); break; } } } } while (0)

struct XcdBarrier {
    unsigned* bar; unsigned x; bool wave0;
    volatile LAS unsigned* st;
};
__device__ __forceinline__ XcdBarrier xcd_barrier_post(unsigned* bar, volatile LAS unsigned* st, int wave) {
    XcdBarrier b; b.bar = bar; b.x = xb_xcc_id(); b.st = st; b.wave0 = (wave == 0);
    if (b.wave0 && hw_lane() == 0) (void)xb_add(&((gu32*)bar)[XB_XCNT(b.x)], 1u);
    return b;
}
__device__ __forceinline__ void xcd_barrier_complete(gu32* bar, unsigned x, unsigned& nloc, unsigned& nx) {
    const unsigned G = gridDim.x * gridDim.y * gridDim.z;
    unsigned sum, cnt, mine, sp = 0u;
    for (;;) {
        sum = 0u; cnt = 0u; mine = 0u;
#pragma unroll
        for (unsigned j = 0; j < 16; ++j) { const unsigned c = xb_ld(&bar[XB_XCNT(j)]); sum += c; cnt += (c > 0u) ? 1u : 0u; mine = (j == x) ? c : mine; }
        if (sum == G) break;
        __builtin_amdgcn_s_sleep(1);
        if ((++sp & 255u) == 0u) { if (xb_ld(&bar[XB_TMO])) break; if (sp > XB_SPIN_CAP) { xb_add(&bar[XB_TMO], 1u); break; } }
    }
    nloc = mine > 0u ? mine : 1u; nx = cnt > 0u ? cnt : 1u;
}
__device__ __forceinline__ void xcd_barrier(const XcdBarrier& b) {
    asm volatile("s_waitcnt vmcnt(0)" ::: "memory");
    __syncthreads();
    if (b.wave0 && hw_lane() == 0) {
        unsigned* bar0 = b.bar; asm volatile("" : "+s"(bar0));
        gu32* bar = (gu32*)bar0;
        __builtin_amdgcn_s_waitcnt(0);
        unsigned nloc = b.st[0], nx = b.st[1];
        if (nloc == 0u) { xcd_barrier_complete(bar, b.x, nloc, nx); b.st[0] = nloc; b.st[1] = nx; }
        const unsigned old = xb_add(&bar[XB_XSUB(b.x)], 1u);
        const unsigned gen = old / nloc;
        if (old + 1u == (gen + 1u) * nloc) {
            __builtin_amdgcn_fence(__ATOMIC_RELEASE, "agent");
            asm volatile("s_waitcnt vmcnt(0)" ::: "memory");
            const unsigned og = xb_add(&bar[XB_TOP], 1u);
            const unsigned tg = og / nx;
            if (og + 1u == (tg + 1u) * nx) xb_add(&bar[XB_TOPGEN], 1u);
            else XB_SPIN(xb_ld(&bar[XB_TOPGEN]) == tg, bar);
            __builtin_amdgcn_fence(__ATOMIC_ACQUIRE, "agent");
            xb_add(&bar[XB_XGEN(b.x)], 1u);
            asm volatile("s_waitcnt vmcnt(0)" ::: "memory");
        } else {
            XB_SPIN(xb_ld(&bar[XB_XGEN(b.x)]) == gen, bar);
            __builtin_amdgcn_fence(__ATOMIC_ACQUIRE, "agent");
            asm volatile("s_waitcnt vmcnt(0)" ::: "memory");
        }
    }
    __syncthreads();
}

__device__ __forceinline__ size_t xb_off(int row, int c) { return (size_t)(row >> 8) * (256 * DM) + (size_t)(c >> 5) * 8192 + (row & 255) * 32 + (c & 31); }
__device__ __forceinline__ float row_scale(const float* ss, int row) {
    const f32x4* p = (const f32x4*)(ss + (size_t)row * 16);
    const f32x4 a = p[0], b = p[1], c = p[2], d = p[3];
    const float s = ((a[0] + a[1]) + (a[2] + a[3])) + ((b[0] + b[1]) + (b[2] + b[3])) + ((c[0] + c[1]) + (c[2] + c[3])) + ((d[0] + d[1]) + (d[2] + d[3]));
    return rsqrtf(s * (1.0f / DM) + EPS);
}
__device__ __forceinline__ float sigmoid_f(float v) { return __builtin_amdgcn_rcpf(1.0f + __builtin_amdgcn_exp2f(-1.44269504f * v)); }
__device__ __forceinline__ float silu_f(float v) { return v * sigmoid_f(v); }
__device__ __forceinline__ float gelu_tanh_f(float v) { const float z = 1.5957691216f * (v + 0.044715f * v * v * v); return v * sigmoid_f(z); }

constexpr int RST_OFF = 131072;
struct RowScaleCache {
    mutable int cached_pm = -1;
    __device__ __forceinline__ void prep(const float* ss, const pg8::Unit& u, PG8_LAS unsigned char* lds, int tid, const int* pos = nullptr) const {
        if (u.pm != cached_pm) {
            if (tid < 256) { ((PG8_LAS float*)(lds + RST_OFF))[tid] = row_scale(ss, u.pm * 256 + tid);
                if (pos) ((PG8_LAS float*)(lds + RST_OFF + 1024))[tid] = (float)pos[u.pm * 256 + tid]; }
            asm volatile("s_waitcnt lgkmcnt(0)" ::: "memory"); __builtin_amdgcn_s_barrier(); asm volatile("" ::: "memory");
            cached_pm = u.pm;
        }
    }
    static __device__ __forceinline__ float get(PG8_LAS unsigned char* lds, int r) { return ((const PG8_LAS float*)(lds + RST_OFF))[r]; }
};
struct EpiSwiGLU {
    static constexpr bool PERM = true, AFTER_DRAIN = false, IDEMP = true; static constexpr int NSTORES = 8;
    pg8::bf16_t* H; const float* ss; PG8_LAS unsigned char* lds; RowScaleCache rc;
    __device__ __forceinline__ void prep(const pg8::Unit& u, PG8_LAS unsigned char* l, int tid) const { rc.prep(ss, u, l, tid); }
    __device__ __forceinline__ void operator()(const pg8::f32x4 (&acc)[2][2][4][2], const pg8::Unit& u, int wr, int wc, int fr, int fq) const {
        const int row0 = u.pm * 256 + wr * 64 + fr, col0 = u.pn * 128 + wc * 32 + 8 * fq;
#pragma unroll
        for (int ai = 0; ai < 2; ++ai)
#pragma unroll
            for (int m = 0; m < 4; ++m) {
                const int row = row0 + ai * 128 + m * 16; const float rs = RowScaleCache::get(lds, row & 255);
                typedef float f32x2 __attribute__((ext_vector_type(2)));
                const float c1 = -1.44269504f * rs, rs2 = rs * rs;
                f32x2 gr[4], ur[4], t[4], o2[4];
#pragma unroll
                for (int n = 0; n < 2; ++n)
#pragma unroll
                    for (int i = 0; i < 2; ++i) { gr[n * 2 + i] = (f32x2){acc[ai][0][m][n][2 * i], acc[ai][0][m][n][2 * i + 1]}; ur[n * 2 + i] = (f32x2){acc[ai][1][m][n][2 * i], acc[ai][1][m][n][2 * i + 1]}; }
#pragma unroll
                for (int j = 0; j < 4; ++j) t[j] = gr[j] * c1;
#pragma unroll
                for (int j = 0; j < 4; ++j) t[j] = (f32x2){__builtin_amdgcn_exp2f(t[j].x), __builtin_amdgcn_exp2f(t[j].y)};
#pragma unroll
                for (int j = 0; j < 4; ++j) { t[j] = t[j] + 1.0f; o2[j] = gr[j] * ur[j]; }
#pragma unroll
                for (int j = 0; j < 4; ++j) t[j] = (f32x2){__builtin_amdgcn_rcpf(t[j].x), __builtin_amdgcn_rcpf(t[j].y)};
#pragma unroll
                for (int j = 0; j < 4; ++j) o2[j] = (o2[j] * rs2) * t[j];
                float o[8];
#pragma unroll
                for (int j = 0; j < 4; ++j) { o[2 * j] = o2[j].x; o[2 * j + 1] = o2[j].y; }
                pg8::u32x4 w; w.x = pg8::cvt_pk_bf16(o[0], o[1]); w.y = pg8::cvt_pk_bf16(o[2], o[3]); w.z = pg8::cvt_pk_bf16(o[4], o[5]); w.w = pg8::cvt_pk_bf16(o[6], o[7]);
                *(pg8::u32x4*)(H + (size_t)u.pm * (256 * DFF) + (size_t)(4 * u.pn + wc) * 8192 + ((row & 255) >> 4) * 512 + fq * 128 + (row & 15) * 8) = w;
#if PROBE_ST == 1
                *(pg8::u32x4*)((char*)H + (size_t)(768u << 20) - (size_t)(360u << 20) + ((((size_t)row * DFF + col0) * 2) & ((256u << 20) - 1))) = w;
#elif PROBE_ST == 2
                *(pg8::u32x4*)((char*)H + (size_t)(768u << 20) - (size_t)(360u << 20) + (((((size_t)(u.pm * 22 + u.pn) * 8 + wr * 4 + wc) * 8 + ai * 4 + m) * 1024 + (fr + 16 * fq) * 16) & ((256u << 20) - 1))) = w;
#endif
            }
    }
};
struct EpiResid {
    static constexpr bool PERM = true, AFTER_DRAIN = false, IDEMP = false; static constexpr int NSTORES = 24;
    pg8::bf16_t* xb; float* ss; float alpha;
    __device__ __forceinline__ void prep(const pg8::Unit&, PG8_LAS unsigned char*, int) const {}
    static __device__ __forceinline__ float row_out(pg8::bf16_t* dst, const pg8::f32x4& o0, const pg8::f32x4& o1, const pg8::f32x4& a0, const pg8::f32x4& a1, float alpha) {
        const pg8::f32x4 v0 = o0 + a0 * alpha, v1 = o1 + a1 * alpha;
        pg8::u32x4 w; w.x = pg8::cvt_pk_bf16(v0[0], v0[1]); w.y = pg8::cvt_pk_bf16(v0[2], v0[3]); w.z = pg8::cvt_pk_bf16(v1[0], v1[1]); w.w = pg8::cvt_pk_bf16(v1[2], v1[3]);
        *(pg8::u32x4*)dst = w;
        const pg8::f32x4 qq = v0 * v0 + v1 * v1;
        return (qq[0] + qq[1]) + (qq[2] + qq[3]);
    }
    __device__ __forceinline__ void operator()(const pg8::f32x4 (&acc)[2][2][4][2], const pg8::Unit& u, int wr, int wc, int fr, int fq) const {
        const int row0 = u.pm * 256 + wr * 64 + fr, col0 = u.pn * 256 + wc * 32 + 8 * fq, ln = fq * 16 + fr;
#pragma unroll
        for (int ai = 0; ai < 2; ++ai) {
            pg8::u32x4 xw[4][2];
#pragma unroll
            for (int m = 0; m < 4; ++m)
#pragma unroll
                for (int bj = 0; bj < 2; ++bj) xw[m][bj] = *(const pg8::u32x4*)(xb + xb_off(row0 + ai * 128 + m * 16, col0 + bj * 128));
            float sq[4];
#pragma unroll
            for (int m = 0; m < 4; ++m) { sq[m] = 0.f;
#pragma unroll
                for (int bj = 0; bj < 2; ++bj) { const pg8::u32x4 w = xw[m][bj];
                    const pg8::f32x4 o0 = (pg8::f32x4){bflo(w.x), bfhi(w.x), bflo(w.y), bfhi(w.y)}, o1 = (pg8::f32x4){bflo(w.z), bfhi(w.z), bflo(w.w), bfhi(w.w)};
                    sq[m] += row_out(xb + xb_off(row0 + ai * 128 + m * 16, col0 + bj * 128), o0, o1, acc[ai][bj][m][0], acc[ai][bj][m][1], alpha); } }
#pragma unroll
            for (int m = 0; m < 4; ++m) { sq[m] += shx(sq[m], 16, ln); }
#pragma unroll
            for (int m = 0; m < 4; ++m) { sq[m] += shx(sq[m], 32, ln); }
#pragma unroll
            for (int m = 0; m < 4; ++m) if (fq == 0) ss[(size_t)(row0 + ai * 128 + m * 16) * 16 + 4 * u.pn + wc] = sq[m];
        }
    }
};
constexpr size_t PREG = (size_t)MTOK * 512;
__device__ __forceinline__ size_t ph_addr(int row, int c) {
    const int r = c >> 9, cc = c & 511, b = row >> 11, sq = row & (SEQ - 1);
    return r < 2 ? (size_t)r * PREG + ((size_t)(((b * NRB + (cc >> 6)) * 2 + ((cc >> 5) & 1)) * SEQ + sq) << 5) + (cc & 31)
                 : (size_t)r * PREG + ((size_t)(((b * NHEAD + (cc >> 7)) * 4 + ((cc >> 5) & 3)) * SEQ + sq) << 5) + (cc & 31);
}
struct EpiProj {
    static constexpr bool PERM = true, AFTER_DRAIN = false, IDEMP = true; static constexpr int NSTORES = 16;
    pg8::bf16_t* P; const float* ss; const int* pos; PG8_LAS unsigned char* lds; RowScaleCache rc;
    __device__ __forceinline__ void prep(const pg8::Unit& u, PG8_LAS unsigned char* l, int tid) const { rc.prep(ss, u, l, tid, pos); }
    __device__ __forceinline__ void operator()(const pg8::f32x4 (&acc)[2][2][4][2], const pg8::Unit& u, int wr, int wc, int fr, int fq) const {
        const int row0 = u.pm * 256 + wr * 64 + fr; const int pn = u.pn;
        if (pn >= 4 && pn < 8) {
            const int jj0 = 32 * (wc & 1) + 8 * fq; const float ksc = (pn >= 6) ? 0.08838834764831845f : 1.0f;
            float inv[8];
#pragma unroll
            for (int j = 0; j < 8; ++j) inv[j] = __builtin_amdgcn_exp2f(-(float)(jj0 + j) * 0.20762050593046014f) * 0.15915494309189535f;
            const int cbase = 256 * pn + 128 * (wc >> 1) + jj0;
            const float dsl = ((pn >= 6) ? -1.0f : 1.0f) * __builtin_amdgcn_logf(1.0f - __builtin_amdgcn_exp2f(-5.0f - (float)(2 * (pn & 1) + (wc >> 1))));
            float pv[2][4];
#pragma unroll
            for (int ai = 0; ai < 2; ++ai)
#pragma unroll
                for (int m = 0; m < 4; ++m) pv[ai][m] = ((const PG8_LAS float*)(lds + RST_OFF + 1024))[(row0 + ai * 128 + m * 16) & 255];
#pragma unroll
            for (int ai = 0; ai < 2; ++ai)
#pragma unroll
                for (int m = 0; m < 4; ++m) {
                    const int row = row0 + ai * 128 + m * 16; const float p = pv[ai][m];
                    const float rs = RowScaleCache::get(lds, row & 255) * ksc * __builtin_amdgcn_exp2f((float)(row & (CHUNK - 1)) * dsl);
                    typedef float f32x2 __attribute__((ext_vector_type(2)));
                    f32x2 rev[4], sn[4], cs[4], t1[4], t2[4], q1[4], q2[4];
#pragma unroll
                    for (int j = 0; j < 4; ++j) rev[j] = (f32x2){inv[2 * j], inv[2 * j + 1]} * p;
#pragma unroll
                    for (int j = 0; j < 4; ++j) rev[j] = (f32x2){__builtin_amdgcn_fractf(rev[j].x), __builtin_amdgcn_fractf(rev[j].y)};
#pragma unroll
                    for (int j = 0; j < 4; ++j) sn[j] = (f32x2){__builtin_amdgcn_sinf(rev[j].x), __builtin_amdgcn_sinf(rev[j].y)};
#pragma unroll
                    for (int j = 0; j < 4; ++j) cs[j] = (f32x2){__builtin_amdgcn_cosf(rev[j].x), __builtin_amdgcn_cosf(rev[j].y)};
#pragma unroll
                    for (int n = 0; n < 2; ++n)
#pragma unroll
                        for (int i = 0; i < 2; ++i) { t1[n * 2 + i] = (f32x2){acc[ai][0][m][n][2 * i], acc[ai][0][m][n][2 * i + 1]} * rs; t2[n * 2 + i] = (f32x2){acc[ai][1][m][n][2 * i], acc[ai][1][m][n][2 * i + 1]} * rs; }
#pragma unroll
                    for (int j = 0; j < 4; ++j) { q1[j] = t1[j] * cs[j] - t2[j] * sn[j]; q2[j] = t1[j] * sn[j] + t2[j] * cs[j]; }
                    float o1[8], o2[8];
#pragma unroll
                    for (int j = 0; j < 4; ++j) { o1[2 * j] = q1[j].x; o1[2 * j + 1] = q1[j].y; o2[2 * j] = q2[j].x; o2[2 * j + 1] = q2[j].y; }
                    pg8::u32x4 w1, w2;
                    w1.x = pg8::cvt_pk_bf16(o1[0], o1[1]); w1.y = pg8::cvt_pk_bf16(o1[2], o1[3]); w1.z = pg8::cvt_pk_bf16(o1[4], o1[5]); w1.w = pg8::cvt_pk_bf16(o1[6], o1[7]);
                    w2.x = pg8::cvt_pk_bf16(o2[0], o2[1]); w2.y = pg8::cvt_pk_bf16(o2[2], o2[3]); w2.z = pg8::cvt_pk_bf16(o2[4], o2[5]); w2.w = pg8::cvt_pk_bf16(o2[6], o2[7]);
                    *(pg8::u32x4*)(P + ph_addr(row, cbase)) = w1; *(pg8::u32x4*)(P + ph_addr(row, cbase + 64)) = w2;
                }
        } else {
            const int act = (pn == 2 || pn == 3) ? 1 : (pn >= 10 ? 2 : 0);
            const int col0 = pn * 256 + wc * 32 + 8 * fq;
#pragma unroll
            for (int ai = 0; ai < 2; ++ai)
#pragma unroll
                for (int m = 0; m < 4; ++m) {
                    const int row = row0 + ai * 128 + m * 16; const float rs = RowScaleCache::get(lds, row & 255);
#pragma unroll
                    for (int bj = 0; bj < 2; ++bj) {
                        typedef float f32x2 __attribute__((ext_vector_type(2)));
                        f32x2 v2[4], z2[4];
#pragma unroll
                        for (int n = 0; n < 2; ++n)
#pragma unroll
                            for (int i = 0; i < 2; ++i) v2[n * 2 + i] = (f32x2){acc[ai][bj][m][n][2 * i], acc[ai][bj][m][n][2 * i + 1]} * rs;
                        if (act != 0) {
                            if (act == 1) {
#pragma unroll
                                for (int j = 0; j < 4; ++j) z2[j] = v2[j] * v2[j];
#pragma unroll
                                for (int j = 0; j < 4; ++j) z2[j] = z2[j] * (0.044715f * -2.302208198f) + (-2.302208198f);
#pragma unroll
                                for (int j = 0; j < 4; ++j) z2[j] = z2[j] * v2[j];
                            } else {
#pragma unroll
                                for (int j = 0; j < 4; ++j) z2[j] = v2[j] * -1.44269504f;
                            }
#pragma unroll
                            for (int j = 0; j < 4; ++j) z2[j] = (f32x2){__builtin_amdgcn_exp2f(z2[j].x), __builtin_amdgcn_exp2f(z2[j].y)};
#pragma unroll
                            for (int j = 0; j < 4; ++j) z2[j] = z2[j] + 1.0f;
#pragma unroll
                            for (int j = 0; j < 4; ++j) z2[j] = (f32x2){__builtin_amdgcn_rcpf(z2[j].x), __builtin_amdgcn_rcpf(z2[j].y)};
#pragma unroll
                            for (int j = 0; j < 4; ++j) v2[j] = v2[j] * z2[j];
                        }
                        float v[8];
#pragma unroll
                        for (int j = 0; j < 4; ++j) { v[2 * j] = v2[j].x; v[2 * j + 1] = v2[j].y; }
                        pg8::u32x4 w; w.x = pg8::cvt_pk_bf16(v[0], v[1]); w.y = pg8::cvt_pk_bf16(v[2], v[3]); w.z = pg8::cvt_pk_bf16(v[4], v[5]); w.w = pg8::cvt_pk_bf16(v[6], v[7]);
                        *(pg8::u32x4*)(P + ph_addr(row, col0 + bj * 128)) = w;
                    }
                }
        }
    }
};

struct Args { const void* in[19]; float* out; unsigned char* ws; int ph_lo, ph_hi, dry, mlim; };
static_assert(sizeof(Args) == 184 && __builtin_offsetof(Args, out) == 152 && __builtin_offsetof(Args, ws) == 160 && __builtin_offsetof(Args, ph_lo) == 168 && __builtin_offsetof(Args, dry) == 176, "KA offsets");
#define CAS __attribute__((address_space(4)))
struct KA {
    static __device__ __forceinline__ const CAS char* base() { const CAS char* kp = (const CAS char*)__builtin_amdgcn_kernarg_segment_ptr(); asm volatile("" : "+s"(kp)); return kp; }
    static __device__ __forceinline__ const void* in(int k) { return *(const void* const CAS*)(base() + 8 * k); }
    static __device__ __forceinline__ float* out() { return *(float* const CAS*)(base() + 152); }
    static __device__ __forceinline__ unsigned char* ws() { return *(unsigned char* const CAS*)(base() + 160); }
    static __device__ __forceinline__ int lo() { return *(const CAS int*)(base() + 168); }
    static __device__ __forceinline__ int hi() { return *(const CAS int*)(base() + 172); }
    static __device__ __forceinline__ int dry() { return *(const CAS int*)(base() + 176); }
    static __device__ __forceinline__ int mlim() { return *(const CAS int*)(base() + 180); }
};
struct Frame {
    LAS unsigned char* lds;
    int wave, G;
    __device__ __forceinline__ int lane_() const { int l = hw_lane(); asm volatile("" : "+v"(l)); return l; }
    __device__ __forceinline__ int tid_() const { int l = hw_lane(); asm volatile("" : "+v"(l)); return wave * 64 + l; }
};
__device__ __forceinline__ float wave_sum(float v, int lane) {
#pragma unroll
    for (int o = 1; o < 64; o <<= 1) v += shx(v, o, lane);
    return v;
}

__device__ __forceinline__ void transpose_item(const float* W, int K, int Nsrc, const float* gain, bf16* WT, int k0, int ndst0, int nsrc0, LAS float* scr, int lane) {
    const int rl = lane >> 3, sg = lane & 7;
    f32x4 v[8]; float gk[8];
#pragma unroll
    for (int i = 0; i < 8; ++i) { const int kk = 8 * i + rl; v[i] = *(const f32x4*)(W + (size_t)(k0 + kk) * Nsrc + nsrc0 + 4 * sg); gk[i] = gain ? gain[k0 + kk] : 1.0f; }
#pragma unroll
    for (int i = 0; i < 8; ++i) { const int kk = 8 * i + rl; LAS float* d = scr + kk * 33 + 4 * sg;
        d[0] = v[i][0] * gk[i]; d[1] = v[i][1] * gk[i]; d[2] = v[i][2] * gk[i]; d[3] = v[i][3] * gk[i]; }
    LDS_WAIT(); asm volatile("" ::: "memory");
    const int c = lane & 7;
#pragma unroll
    for (int j = 0; j < 4; ++j) { const int n = (lane >> 3) + 8 * j; const LAS float* s = scr + (8 * c) * 33 + n;
        v4u o; o.x = pk2(s[0 * 33], s[1 * 33]); o.y = pk2(s[2 * 33], s[3 * 33]); o.z = pk2(s[4 * 33], s[5 * 33]); o.w = pk2(s[6 * 33], s[7 * 33]);
#if WEIGHTS_BLOCKED
        const int nd = ndst0 + 16 * ((n >> 2) & 1) + 4 * (n >> 3) + (n & 3);
        *(v4u*)(WT + (size_t)(nd >> 8) * (256 * (size_t)K) + (size_t)((k0 >> 5) + (c >> 2)) * 8192 + (nd & 255) * 32 + 8 * (c & 3)) = o; }
#else
        *(v4u*)(WT + (size_t)(ndst0 + n) * K + k0 + 8 * c) = o; }
#endif
    LDS_WAIT(); asm volatile("" ::: "memory");
}
__device__ __forceinline__ int map_ffn(int n) { const int pn = n >> 8, bj = (n >> 7) & 1, c = n & 127; return bj * DFF + 128 * pn + c; }
__device__ __forceinline__ int map_proj(int n) { const int pn = n >> 8; if (pn < 4 || pn >= 8) return n; const int bj = (n >> 7) & 1, cc = n & 127; return 256 * pn + 128 * (cc >> 6) + 64 * bj + (cc & 63); }

__device__ __forceinline__ void phase_prep(const Frame& F, const Args& a) {
    LAS float* scr = (LAS float*)(F.lds + F.wave * 16384);
    const int gw = blockIdx.x * NWAVES + F.wave, NGW = F.G * NWAVES;
    constexpr int I_FIN = (DM / 64) * (NFF / 32), I_FOUT = (DFF / 64) * (DM / 32), I_IN = (DM / 64) * (DIN / 32), I_OUT = (DM / 64) * (DM / 32);
    constexpr int I_LAYER = 2 * I_FIN + 2 * I_FOUT + I_IN + I_OUT;
    for (int it = gw; it < DEPTH * I_LAYER; it += NGW) {
        const int l = it / I_LAYER; int r = it % I_LAYER;
        unsigned char* wl = KA::ws() + WS_W + (size_t)l * SZ_WLAYER;
        const float* W; const float* gain; bf16* WT; int K, N, mode;
        if (r < I_FIN) { W = (const float*)KA::in(3) + (size_t)l * DM * NFF; gain = (const float*)KA::in(2) + l * DM; WT = (bf16*)(wl + OFF_W1IN); K = DM; N = NFF; mode = 1; }
        else if ((r -= I_FIN) < I_FOUT) { W = (const float*)KA::in(4) + (size_t)l * DFF * DM; gain = nullptr; WT = (bf16*)(wl + OFF_W1OUT); K = DFF; N = DM; mode = 0; }
        else if ((r -= I_FOUT) < I_IN) { W = (const float*)KA::in(6) + (size_t)l * DM * DIN; gain = (const float*)KA::in(5) + l * DM; WT = (bf16*)(wl + OFF_WIN); K = DM; N = DIN; mode = 2; }
        else if ((r -= I_IN) < I_OUT) { W = (const float*)KA::in(14) + (size_t)l * DM * DM; gain = nullptr; WT = (bf16*)(wl + OFF_WOUT); K = DM; N = DM; mode = 0; }
        else if ((r -= I_OUT) < I_FIN) { W = (const float*)KA::in(16) + (size_t)l * DM * NFF; gain = (const float*)KA::in(15) + l * DM; WT = (bf16*)(wl + OFF_W2IN); K = DM; N = NFF; mode = 1; }
        else { r -= I_FIN; W = (const float*)KA::in(17) + (size_t)l * DFF * DM; gain = nullptr; WT = (bf16*)(wl + OFF_W2OUT); K = DFF; N = DM; mode = 0; }
        const int nblk = N / 32, kb = r / nblk, nb = r % nblk, n0 = 32 * nb;
        const int ns0 = mode == 1 ? map_ffn(n0) : (mode == 2 ? map_proj(n0) : n0);
        transpose_item(W, K, N, gain, WT, 64 * kb, n0, ns0, scr, F.lane_());
    }
    const float* x = (const float*)KA::in(0); bf16* xb = (bf16*)(KA::ws() + WS_XB); float* ss = (float*)(KA::ws() + WS_SS);
    for (int m2 = gw; m2 < MTOK / 2; m2 += NGW) {
        const int m = 2 * m2; const int lane = F.lane_(); f32x4 v[2][4]; float s[2];
#pragma unroll
        for (int r = 0; r < 2; ++r) { const f32x4* xr = (const f32x4*)(x + (size_t)(m + r) * DM) + lane;
#pragma unroll
            for (int j = 0; j < 4; ++j) v[r][j] = xr[64 * j]; }
#pragma unroll
        for (int r = 0; r < 2; ++r) { s[r] = 0.f;
#pragma unroll
            for (int j = 0; j < 4; ++j) s[r] += (v[r][j][0] * v[r][j][0] + v[r][j][1] * v[r][j][1]) + (v[r][j][2] * v[r][j][2] + v[r][j][3] * v[r][j][3]); }
#pragma unroll
        for (int o = 1; o < 64; o <<= 1) { s[0] += shx(s[0], o, lane); s[1] += shx(s[1], o, lane); }
#pragma unroll
        for (int r = 0; r < 2; ++r) {
#pragma unroll
            for (int j = 0; j < 4; ++j) { v2u w; w.x = pk2(v[r][j][0], v[r][j][1]); w.y = pk2(v[r][j][2], v[r][j][3]); *(v2u*)(xb + xb_off(m + r, 4 * lane + 256 * j)) = w; }
            if (lane < 16) ss[(size_t)(m + r) * 16 + lane] = lane == 0 ? s[r] : 0.f; }
    }
}
__device__ __forceinline__ void phase_final(const Frame& F, const Args& a) {
    const int gw = blockIdx.x * NWAVES + F.wave, NGW = F.G * NWAVES;
    const bf16* xb = (const bf16*)(KA::ws() + WS_XB); float* out = KA::out();
    const f32x4* gp = (const f32x4*)KA::in(18) + 2 * F.lane_(); f32x4 gn[4];
#pragma unroll
    for (int j = 0; j < 2; ++j) { gn[2 * j] = gp[128 * j]; gn[2 * j + 1] = gp[128 * j + 1]; }
    for (int m4 = gw; m4 < MTOK / 4; m4 += NGW) {
        const int m = 4 * m4; const int lane = F.lane_(); v4u w[4][2]; float s[4];
#pragma unroll
        for (int r = 0; r < 4; ++r) { w[r][0] = *(const v4u*)(xb + xb_off(m + r, 8 * lane)); w[r][1] = *(const v4u*)(xb + xb_off(m + r, 512 + 8 * lane)); }
#pragma unroll
        for (int r = 0; r < 4; ++r) { s[r] = 0.f;
#pragma unroll
            for (int j = 0; j < 2; ++j) { const v4u q = w[r][j]; const float a0 = bflo(q.x), a1 = bfhi(q.x), a2 = bflo(q.y), a3 = bfhi(q.y), a4 = bflo(q.z), a5 = bfhi(q.z), a6 = bflo(q.w), a7 = bfhi(q.w);
                s[r] += ((a0 * a0 + a1 * a1) + (a2 * a2 + a3 * a3)) + ((a4 * a4 + a5 * a5) + (a6 * a6 + a7 * a7)); } }
#pragma unroll
        for (int o = 1; o < 64; o <<= 1) {
#pragma unroll
            for (int r = 0; r < 4; ++r) s[r] += shx(s[r], o, lane); }
#pragma unroll
        for (int r = 0; r < 4; ++r) {
            float rs = rsqrtf(s[r] * (1.0f / DM) + EPS);
#if PROBE_TMASK
            rs *= 1.0f + sqrtf((float)__hip_atomic_load((unsigned*)(KA::ws() + WS_CTL) + 64, __ATOMIC_RELAXED, __HIP_MEMORY_SCOPE_AGENT) * 1e-5f);
#endif
            f32x4* orow = (f32x4*)(out + (size_t)(m + r) * DM) + 2 * lane;
#pragma unroll
            for (int j = 0; j < 2; ++j) { const v4u q = w[r][j];
                orow[128 * j] = (f32x4){bflo(q.x), bfhi(q.x), bflo(q.y), bfhi(q.y)} * rs * gn[2 * j]; orow[128 * j + 1] = (f32x4){bflo(q.z), bfhi(q.z), bflo(q.w), bfhi(q.w)} * rs * gn[2 * j + 1]; }
        }
    }
}

constexpr int L_WA = 0, L_WX = 9216, L_RAW = 18432, L_XCB = 35200, L_XCF = 53632, L_AA = 86400, L_CAR = 119168, L_END = 123264;
static_assert(L_END <= MISC_OFF, "lru lds");
__device__ __forceinline__ void lru_unit3(const Frame& F, const Args& a, int layer, int b, int j) {
    LAS unsigned char* lds = F.lds;
    const bf16* XR = (const bf16*)(KA::ws() + WS_PH) + (size_t)(b * NRB + j) * SEQ * 64;
    const bf16* GT = XR + PREG;
    bf16* Y = (bf16*)(KA::ws() + WS_Y);
    const float* gaw = (const float*)KA::in(9) + ((size_t)layer * NRB + j) * RB * RB; const float* gxw = (const float*)KA::in(11) + ((size_t)layer * NRB + j) * RB * RB;
    const float* gab = (const float*)KA::in(10) + layer * DRNN + j * RB; const float* gxb = (const float*)KA::in(12) + layer * DRNN + j * RB;
    const float* lam = (const float*)KA::in(13) + layer * DRNN + j * RB;
    const float* cw = (const float*)KA::in(7) + (size_t)layer * 4 * DRNN + j * RB; const float* cb = (const float*)KA::in(8) + layer * DRNN + j * RB;
    const int w = F.wave;
    const int tid0 = F.tid_(), lane0 = tid0 & 63, col0 = lane0 & 15, q0 = lane0 >> 4;
    LDS_BARRIER();
#pragma unroll
    for (int r = 0; r < 8; ++r) { const int e = tid0 + 512 * r, i = e >> 6, o = e & 63;
        ((LAS bf16*)(lds + L_WA))[o * 72 + i] = (bf16)f2bf(-1.44269504f * gaw[e]); ((LAS bf16*)(lds + L_WX))[o * 72 + i] = (bf16)f2bf(-1.44269504f * gxw[e]); }
    float cwk[4];
#pragma unroll
    for (int k = 0; k < 4; ++k) cwk[k] = cw[k * DRNN + lane0];
    const float cbias = cb[lane0];
    float ba[4], bx[4], cl[4];
#pragma unroll
    for (int ob = 0; ob < 4; ++ob) { const int o = 16 * ob + col0; ba[ob] = -1.44269504f * gab[o]; bx[ob] = -1.44269504f * gxb[o];
        const float nl = -lam[o]; const float sp = (nl > 20.f) ? nl : log1pf(__expf(nl));
        cl[ob] = -8.0f * sp * 1.44269504f; }
    LDS_BARRIER();
    bf16x8 wfa[4][2], wfx[4][2];
#pragma unroll
    for (int ob = 0; ob < 4; ++ob)
#pragma unroll
        for (int s = 0; s < 2; ++s) { wfa[ob][s] = *(const LAS bf16x8*)(lds + L_WA + ((16 * ob + col0) * 72 + 32 * s + 8 * q0) * 2); wfx[ob][s] = *(const LAS bf16x8*)(lds + L_WX + ((16 * ob + col0) * 72 + 32 * s + 8 * q0) * 2); }
    float hcar = 0.f;
    const v4u* rpx = (const v4u*)XR + tid0; const v4u* rpg = (const v4u*)GT + tid0;
    v4u rawp[2], gtp[2];
    constexpr int CB = SEQ * 4;
    rawp[0] = rpx[0]; rawp[1] = rpx[CB]; gtp[0] = rpg[0]; gtp[1] = rpg[CB];
    for (int step = 0; step < SEQ / 128; ++step) {
        const int t0 = step * 128;
        const int tid = F.tid_(), lane = tid & 63, col = lane & 15, q = lane >> 4;
        LAS unsigned char* gt = lds + L_AA + 16384 * (step & 1);
        {
            const int pr = tid >> 2, ps = (tid & 3) * 16;
            if (tid >= 500) { const int hr = pr - 125;
                v4u h0 = (v4u){0u, 0u, 0u, 0u}, h1 = h0; if (step > 0) { h0 = *(const LAS v4u*)(lds + L_RAW + (128 + hr) * 128 + ps); h1 = *(const LAS v4u*)(lds + L_RAW + (128 + hr) * 128 + 64 + ps); }
                *(LAS v4u*)(lds + L_RAW + hr * 128 + ps) = h0; *(LAS v4u*)(lds + L_RAW + hr * 128 + 64 + ps) = h1; }
            *(LAS v4u*)(lds + L_RAW + (3 + pr) * 128 + ps) = rawp[0]; *(LAS v4u*)(lds + L_RAW + (3 + pr) * 128 + 64 + ps) = rawp[1];
            *(LAS v4u*)(gt + pr * 128 + ps) = gtp[0]; *(LAS v4u*)(gt + pr * 128 + 64 + ps) = gtp[1];
            const int adv = (step + 1 < SEQ / 128 ? step + 1 : step) * 512;
            rawp[0] = rpx[adv]; rawp[1] = rpx[adv + CB]; gtp[0] = rpg[adv]; gtp[1] = rpg[adv + CB];
        }
        LDS_BARRIER();
        if (step > 0) {
#pragma unroll
            for (int r = 0; r < 2; ++r) { const int p = tid + 512 * r, row = p >> 3, seg = p & 7;
                *(v4u*)(Y + (size_t)(b * SEQ + t0 - 128 + row) * DM + j * RB + 8 * seg) = *(const LAS v4u*)(lds + L_AA + 16384 * ((step - 1) & 1) + row * 128 + seg * 16); }
        }
        {
            float rw[19];
#pragma unroll
            for (int i = 0; i < 19; ++i) rw[i] = bf2f(((const LAS bf16*)(lds + L_RAW))[(16 * w + i) * 64 + lane]);
            float xcv[16];
#pragma unroll
            for (int r = 0; r < 16; ++r) xcv[r] = cbias + cwk[0] * rw[r] + cwk[1] * rw[r + 1] + cwk[2] * rw[r + 2] + cwk[3] * rw[r + 3];
#pragma unroll
            for (int r = 0; r < 16; ++r) { ((LAS float*)(lds + L_XCF))[(16 * w + r) * 64 + lane] = xcv[r]; ((LAS bf16*)(lds + L_XCB))[(16 * w + r) * 72 + lane] = (bf16)f2bf(xcv[r]); }
        }
        LDS_WAIT();
        float hl[4][4], pl[4][4];
        {
            bf16x8 af[2];
#pragma unroll
            for (int s = 0; s < 2; ++s) af[s] = *(const LAS bf16x8*)(lds + L_XCB + ((16 * w + col) * 72 + 32 * s + 8 * q) * 2);
            float xc[4][4];
#pragma unroll
            for (int ob = 0; ob < 4; ++ob)
#pragma unroll
                for (int r = 0; r < 4; ++r) xc[ob][r] = ((const LAS float*)(lds + L_XCF))[(16 * w + 4 * q + r) * 64 + 16 * ob + col];
#pragma unroll
            for (int ob = 0; ob < 4; ++ob) {
                f32x4 za = (f32x4){ba[ob], ba[ob], ba[ob], ba[ob]}, zx = (f32x4){bx[ob], bx[ob], bx[ob], bx[ob]};
#pragma unroll
                for (int s = 0; s < 2; ++s) { za = __builtin_amdgcn_mfma_f32_16x16x32_bf16(af[s], wfa[ob][s], za, 0, 0, 0); zx = __builtin_amdgcn_mfma_f32_16x16x32_bf16(af[s], wfx[ob][s], zx, 0, 0, 0); }
                float hrun = 0.f, prun = 1.f;
#pragma unroll
                for (int hh = 0; hh < 2; ++hh) {
                    typedef float f32x2 __attribute__((ext_vector_type(2)));
                    const f32x2 one = (f32x2){1.0f, 1.0f};
                    const f32x2 da = (f32x2){__builtin_amdgcn_exp2f(za[2 * hh]), __builtin_amdgcn_exp2f(za[2 * hh + 1])} + one, dx = (f32x2){__builtin_amdgcn_exp2f(zx[2 * hh]), __builtin_amdgcn_exp2f(zx[2 * hh + 1])} + one;
                    const f32x2 ra = (f32x2){__builtin_amdgcn_rcpf(da.x), __builtin_amdgcn_rcpf(da.y)}, ri = (f32x2){__builtin_amdgcn_rcpf(dx.x), __builtin_amdgcn_rcpf(dx.y)};
                    const f32x2 yy = ra * cl[ob];
                    const f32x2 av = (f32x2){__builtin_amdgcn_exp2f(yy.x), __builtin_amdgcn_exp2f(yy.y)};
                    const f32x2 om = __builtin_elementwise_fma(-av, av, one);
                    const f32x2 uu = (f32x2){__builtin_amdgcn_sqrtf(om.x), __builtin_amdgcn_sqrtf(om.y)} * ri * (f32x2){xc[ob][2 * hh], xc[ob][2 * hh + 1]};
                    hrun = av.x * hrun + uu.x; prun = prun * av.x; hl[ob][2 * hh] = hrun; pl[ob][2 * hh] = prun;
                    hrun = av.y * hrun + uu.y; prun = prun * av.y; hl[ob][2 * hh + 1] = hrun; pl[ob][2 * hh + 1] = prun;
                }
            }
        }
        float pe[4], he[4];
        {
            float pg[4][4], hg[4][4];
#pragma unroll
            for (int ob = 0; ob < 4; ++ob)
#pragma unroll
                for (int g = 0; g < 4; ++g) { int ad = (col + 16 * g) << 2; asm volatile("" : "+v"(ad));
                                              pg[ob][g] = __builtin_bit_cast(float, __builtin_amdgcn_ds_bpermute(ad, __builtin_bit_cast(int, pl[ob][3])));
                                              hg[ob][g] = __builtin_bit_cast(float, __builtin_amdgcn_ds_bpermute(ad, __builtin_bit_cast(int, hl[ob][3]))); }
            LDS_WAIT();
#pragma unroll
            for (int ob = 0; ob < 4; ++ob) {
                float pacc = 1.f, hacc = 0.f; pe[ob] = 1.f; he[ob] = 0.f;
#pragma unroll
                for (int g = 0; g < 4; ++g) { if (g == q) { pe[ob] = pacc; he[ob] = hacc; } hacc = pg[ob][g] * hacc + hg[ob][g]; pacc = pacc * pg[ob][g]; }
                if (q == 0) { v2u cw2; cw2.x = __builtin_bit_cast(unsigned, pacc); cw2.y = __builtin_bit_cast(unsigned, hacc); *(LAS v2u*)(lds + L_CAR + (w * 64 + 16 * ob + col) * 8) = cw2; }
            }
        }
        LDS_BARRIER();
        {
            unsigned short gv[4][4];
#pragma unroll
            for (int ob = 0; ob < 4; ++ob)
#pragma unroll
                for (int r = 0; r < 4; ++r) gv[ob][r] = ((const LAS bf16*)gt)[(16 * w + 4 * q + r) * 64 + 16 * ob + col];
            v2u cr[8];
#pragma unroll
            for (int w2 = 0; w2 < 8; ++w2) cr[w2] = *(const LAS v2u*)(lds + L_CAR + (w2 * 64 + 16 * q + col) * 8);
            float hinq = hcar, hall = hcar;
#pragma unroll
            for (int w2 = 0; w2 < 8; ++w2) { const unsigned ppu = cr[w2].x, hhu = cr[w2].y; const float pp = __uint_as_float(ppu), hh = __uint_as_float(hhu);
                hall = pp * hall + hh; if (w2 < w) hinq = pp * hinq + hh; }
            hcar = hall;
#pragma unroll
            for (int ob = 0; ob < 4; ++ob) {
                const float hin = __builtin_bit_cast(float, __builtin_amdgcn_ds_bpermute((col + 16 * ob) << 2, __builtin_bit_cast(int, hinq)));
                const float cin = he[ob] + pe[ob] * hin;
#pragma unroll
                for (int r = 0; r < 4; ++r) { const float h = hl[ob][r] + pl[ob][r] * cin;
                    LAS bf16* gp = (LAS bf16*)gt + (16 * w + 4 * q + r) * 64 + 16 * ob + col; *gp = (bf16)f2bf(h * bf2f(gv[ob][r]));
                }
            }
        }
    }
    {
        const int tid = F.tid_();
        LDS_BARRIER();
#pragma unroll
        for (int r = 0; r < 2; ++r) { const int p = tid + 512 * r, row = p >> 3, seg = p & 7;
            *(v4u*)(Y + (size_t)(b * SEQ + SEQ - 128 + row) * DM + j * RB + 8 * seg) = *(const LAS v4u*)(lds + L_AA + 16384 * ((SEQ / 128 - 1) & 1) + row * 128 + seg * 16); }
    }
}

constexpr int RS = 136;
constexpr int R_KI = 0, R_KT = 34816, R_VT = 69632, R_PT = 104448, R_END = 139264;
static_assert(R_END <= MISC_OFF, "retention lds");
typedef short s16x4 __attribute__((ext_vector_type(4)));
constexpr int RS2 = 144;
constexpr int R2_KI = 0, R2_VI = 36864, R2_PT = 73728, R2_END = 110592;
static_assert(R2_END <= MISC_OFF, "retention v2 lds");
__device__ __forceinline__ bf16x8 tr_pair(LAS unsigned char* p0, LAS unsigned char* p1) {
    const s16x4 lo = __builtin_amdgcn_ds_read_tr16_b64_v4i16((LAS s16x4*)p0), hi = __builtin_amdgcn_ds_read_tr16_b64_v4i16((LAS s16x4*)p1);
    return __builtin_shufflevector(lo, hi, 0, 1, 2, 3, 4, 5, 6, 7);
}
__device__ __forceinline__ void ret_unit3(const Frame& F, const Args& a, int b, int hh) {
    LAS unsigned char* lds = F.lds;
    const bf16* Qg = (const bf16*)(KA::ws() + WS_PH) + 2 * PREG + (size_t)(b * NHEAD + hh) * SEQ * 128;
    const bf16* Kg = Qg + PREG; const bf16* Vg = Kg + PREG; const bf16* Gg = Vg + PREG;
    constexpr size_t HB = (size_t)SEQ * 32;
    bf16* Y = (bf16*)(KA::ws() + WS_Y);
    const float gamma = 1.0f - __builtin_amdgcn_exp2f(-5.0f - (float)hh); const float lg = __builtin_amdgcn_logf(gamma);
    const float cdecay = __builtin_amdgcn_exp2f(128.0f * lg);
    f32x4 kvacc[8];
#pragma unroll
    for (int d = 0; d < 8; ++d) kvacc[d] = (f32x4){0.f, 0.f, 0.f, 0.f};
    v4u pk_[4], pv_[4]; bf16x8 qn[4];
    {
        const int tid = F.tid_(), lane = tid & 63, col = lane & 15, q = lane >> 4; const size_t row0 = 0;
#pragma unroll
        for (int i = 0; i < 4; ++i) { const int m = tid >> 2, q4 = tid & 3;
            pk_[i] = *(const v4u*)(Kg + (size_t)i * HB + (row0 + m) * 32 + 8 * q4); pv_[i] = *(const v4u*)(Vg + (size_t)i * HB + (row0 + m) * 32 + 8 * q4); }
#pragma unroll
        for (int s = 0; s < 4; ++s) qn[s] = *(const bf16x8*)(Qg + (size_t)s * HB + (row0 + 16 * F.wave + col) * 32 + 8 * q);
    }
    for (int n = 0; n < NCHUNK; ++n) {
        int tid = F.tid_(), w = F.wave; asm volatile("" : "+v"(tid)); asm volatile("" : "+s"(w));
        const int lane = tid & 63, col = lane & 15, q = lane >> 4;
        const size_t row0 = (size_t)b * SEQ + (size_t)n * CHUNK, tok0 = (size_t)n * CHUNK;
        LDS_BARRIER();
#pragma unroll
        for (int i = 0; i < 4; ++i) { const int m = tid >> 2, d8 = 4 * i + (tid & 3);
            *(LAS v4u*)(lds + R2_KI + (m * RS2 + 8 * d8) * 2) = pk_[i]; *(LAS v4u*)(lds + R2_VI + (m * RS2 + 8 * d8) * 2) = pv_[i]; }
#pragma unroll
        for (int db = 0; db < 8; ++db) { v2u pw; pw.x = pk2(kvacc[db][0], kvacc[db][1]); pw.y = pk2(kvacc[db][2], kvacc[db][3]);
            *(LAS v2u*)(lds + R2_PT + ((16 * w + col) * RS2 + 16 * db + 4 * q) * 2) = pw; }
        bf16x8 qf[4];
#pragma unroll
        for (int s = 0; s < 4; ++s) qf[s] = qn[s];
        LDS_BARRIER();
        if (n + 1 < NCHUNK) {
            const size_t rown = tok0 + CHUNK;
#pragma unroll
            for (int i = 0; i < 4; ++i) { const int m = tid >> 2, q4 = tid & 3;
                pk_[i] = *(const v4u*)(Kg + (size_t)i * HB + (rown + m) * 32 + 8 * q4); pv_[i] = *(const v4u*)(Vg + (size_t)i * HB + (rown + m) * 32 + 8 * q4); }
#pragma unroll
            for (int s = 0; s < 4; ++s) qn[s] = *(const bf16x8*)(Qg + (size_t)s * HB + (rown + 16 * w + col) * 32 + 8 * q);
        }
        v2u gpre[8];
#pragma unroll
        for (int eb = 0; eb < 8; ++eb) gpre[eb] = *(const v2u*)(Gg + (size_t)(eb >> 1) * HB + (tok0 + 16 * w + col) * 32 + 16 * (eb & 1) + 4 * q);
#define SCHED_FENCE() __builtin_amdgcn_sched_barrier(0)
        f32x4 out[8];
        {
            bf16x8 pf[2][8];
#pragma unroll
            for (int eb = 0; eb < 8; ++eb) { out[eb] = (f32x4){0.f, 0.f, 0.f, 0.f}; pf[0][eb] = *(const LAS bf16x8*)(lds + R2_PT + ((16 * eb + col) * RS2 + 8 * q) * 2); }
#pragma unroll
            for (int s = 0; s < 4; ++s) {
                if (s < 3) {
#pragma unroll
                    for (int eb = 0; eb < 8; ++eb) pf[(s + 1) & 1][eb] = *(const LAS bf16x8*)(lds + R2_PT + ((16 * eb + col) * RS2 + 32 * (s + 1) + 8 * q) * 2);
                }
                SCHED_FENCE();
#pragma unroll
                for (int eb = 0; eb < 8; ++eb) out[eb] = __builtin_amdgcn_mfma_f32_16x16x32_bf16(pf[s & 1][eb], qf[s], out[eb], 0, 0, 0);
                SCHED_FENCE();
            }
#pragma unroll
            for (int eb = 0; eb < 8; ++eb) out[eb] = out[eb] * cdecay;
        }
        LAS unsigned char* trV = lds + R2_VI + ((col >> 2) * RS2 + 4 * (col & 3)) * 2;
        LAS unsigned char* trK = lds + R2_KI + ((col >> 2) * RS2 + 4 * (col & 3)) * 2;
#pragma unroll
        for (int t = 0; t < 4; ++t) {
            if (2 * t <= w) {
                bf16x8 ka[4], kb[4], vf[8];
#pragma unroll
                for (int s = 0; s < 4; ++s) { ka[s] = *(const LAS bf16x8*)(lds + R2_KI + ((32 * t + col) * RS2 + 32 * s + 8 * q) * 2);
                                              kb[s] = *(const LAS bf16x8*)(lds + R2_KI + ((32 * t + 16 + col) * RS2 + 32 * s + 8 * q) * 2); }
#pragma unroll
                for (int eb = 0; eb < 8; ++eb) vf[eb] = tr_pair(trV + ((32 * t + 4 * q) * RS2 + 16 * eb) * 2, trV + ((32 * t + 16 + 4 * q) * RS2 + 16 * eb) * 2);
                SCHED_FENCE();
                f32x4 sa = (f32x4){0.f, 0.f, 0.f, 0.f}, sb = (f32x4){0.f, 0.f, 0.f, 0.f};
#pragma unroll
                for (int s = 0; s < 4; ++s) { sa = __builtin_amdgcn_mfma_f32_16x16x32_bf16(ka[s], qf[s], sa, 0, 0, 0); sb = __builtin_amdgcn_mfma_f32_16x16x32_bf16(kb[s], qf[s], sb, 0, 0, 0); }
                const int c = 16 * w + col;
                float va[4], vb[4];
#pragma unroll
                for (int r = 0; r < 4; ++r) { const int ma = 32 * t + 4 * q + r, mb = ma + 16;
                    va[r] = (c >= ma) ? sa[r] : 0.f; vb[r] = (c >= mb) ? sb[r] : 0.f; }
                v4u sw; sw.x = pk2(va[0], va[1]); sw.y = pk2(va[2], va[3]); sw.z = pk2(vb[0], vb[1]); sw.w = pk2(vb[2], vb[3]);
                const bf16x8 sfr = __builtin_bit_cast(bf16x8, sw);
                SCHED_FENCE();
#pragma unroll
                for (int eb = 0; eb < 8; ++eb) out[eb] = __builtin_amdgcn_mfma_f32_16x16x32_bf16(vf[eb], sfr, out[eb], 0, 0, 0);
                SCHED_FENCE();
            }
        }
        {
            float sq = 0.f;
#pragma unroll
            for (int eb = 0; eb < 8; ++eb) sq += (out[eb][0] * out[eb][0] + out[eb][1] * out[eb][1]) + (out[eb][2] * out[eb][2] + out[eb][3] * out[eb][3]);
            sq += shx(sq, 16, lane); sq += shx(sq, 32, lane);
            const float rs = rsqrtf(sq * (1.0f / DH) + EPS);
            const size_t row = row0 + 16 * w + col;
#pragma unroll
            for (int eb = 0; eb < 8; ++eb) {
                const v2u gw2 = gpre[eb];
                v2u o; o.x = pk2(out[eb][0] * rs * bflo(gw2.x), out[eb][1] * rs * bfhi(gw2.x)); o.y = pk2(out[eb][2] * rs * bflo(gw2.y), out[eb][3] * rs * bfhi(gw2.y));
                *(v2u*)(Y + row * DM + DRNN + 128 * hh + 16 * eb + 4 * q) = o;
            }
        }
        {
            bf16x8 vfz[4];
#pragma unroll
            for (int t = 0; t < 4; ++t) vfz[t] = tr_pair(trV + ((32 * t + 8 * q) * RS2 + 16 * w) * 2, trV + ((32 * t + 8 * q + 4) * RS2 + 16 * w) * 2);
#pragma unroll
            for (int dp = 0; dp < 4; ++dp) {
                bf16x8 kf[2][4];
#pragma unroll
                for (int h2 = 0; h2 < 2; ++h2)
#pragma unroll
                    for (int t = 0; t < 4; ++t) kf[h2][t] = tr_pair(trK + ((32 * t + 8 * q) * RS2 + 16 * (2 * dp + h2)) * 2, trK + ((32 * t + 8 * q + 4) * RS2 + 16 * (2 * dp + h2)) * 2);
                SCHED_FENCE();
                f32x4 c0 = kvacc[2 * dp] * cdecay, c1 = kvacc[2 * dp + 1] * cdecay;
#pragma unroll
                for (int t = 0; t < 4; ++t) { c0 = __builtin_amdgcn_mfma_f32_16x16x32_bf16(kf[0][t], vfz[t], c0, 0, 0, 0); c1 = __builtin_amdgcn_mfma_f32_16x16x32_bf16(kf[1][t], vfz[t], c1, 0, 0, 0); }
                kvacc[2 * dp] = c0; kvacc[2 * dp + 1] = c1;
                SCHED_FENCE();
            }
        }
    }
}

__global__ void __launch_bounds__(NWAVES * 64, 2) hymba_fwd(Args args) {
    extern __shared__ __attribute__((aligned(16))) unsigned char lds_raw[];
    Frame F;
    F.lds = (LAS unsigned char*)lds_raw;
    F.wave = __builtin_amdgcn_readfirstlane((int)threadIdx.x >> 6); F.G = gridDim.x;
    unsigned char* ws = KA::ws();
    const int lo = KA::lo(), hi = KA::hi();
    if (F.tid_() < 16) ((LAS unsigned*)(F.lds + MISC_OFF))[F.tid_()] = 0u;
#if PROBE_TMASK
    __syncthreads(); if (F.tid_() == 0) { volatile LAS unsigned long long* tm = (volatile LAS unsigned long long*)(F.lds + MISC_OFF + 16); tm[0] = __builtin_amdgcn_s_memrealtime(); tm[1] = 0ull; }
#endif
    __syncthreads();
    XcdBarrier bar; bar.bar = (unsigned*)(ws + WS_CTL) + CW_BAR; bar.x = 0; bar.st = nullptr; bar.wave0 = false;
    if (hi - lo > 1) bar = xcd_barrier_post((unsigned*)(ws + WS_CTL) + CW_BAR, (volatile LAS unsigned*)(F.lds + MISC_OFF), F.wave);
#define IN(k) (lo <= (k) && (k) < hi)
#if PROBE_TMASK
#define SEAM(k) do { if (blockIdx.x == 0 && F.tid_() == 0) { volatile LAS unsigned long long* tm = (volatile LAS unsigned long long*)(F.lds + MISC_OFF + 16); const unsigned long long tn = __builtin_amdgcn_s_memrealtime(); \
        if ((PROBE_TMASK >> (k)) & 1) tm[1] += tn - tm[0]; tm[0] = tn; \
        if ((k) == 7 * DEPTH) __hip_atomic_store((unsigned*)(ws + WS_CTL) + 64, (unsigned)tm[1], __ATOMIC_RELAXED, __HIP_MEMORY_SCOPE_AGENT); } \
    if (IN(k) && IN((k) + 1)) xcd_barrier(bar); } while (0)
#else
#define SEAM(k) do { if (IN(k) && IN((k) + 1)) xcd_barrier(bar); } while (0)
#endif

    bf16* XB = (bf16*)(ws + WS_XB); float* SS = (float*)(ws + WS_SS); bf16* YB = (bf16*)(ws + WS_Y); bf16* PH = (bf16*)(ws + WS_PH);

#ifndef SK_PREP
    if (IN(0)) { phase_prep(F, args); }
#endif

    SEAM(0);
    for (int sb = 0; sb < 3 * DEPTH; ++sb) {
        const int l = sb / 3, t = sb % 3; const int p0 = 1 + 7 * l + (t == 0 ? 0 : (t == 1 ? 2 : 5));
        unsigned char* wl = ws + WS_W + (size_t)l * SZ_WLAYER;
        if (t != 1) {
#ifndef SK_FFNIN
            if (IN(p0)) {
                const int mrows = KA::mlim() ? KA::mlim() : MTOK;
                pg8::Gemm g{XB, (const bf16*)(wl + (t == 0 ? OFF_W1IN : OFF_W2IN)), mrows, NFF, DM}; pg8::StaticOrder S; S.init(mrows, NFF, F.G, (int)blockIdx.x);
                EpiSwiGLU E{PH, SS, F.lds, {}};
                pg8::gemm_phase<EpiSwiGLU, pg8::StaticOrder, PG8_ALIGN, PG8_SP2, true>(F.lds, g, S, E, F.wave);
            }
#endif

            SEAM(p0);
#ifndef SK_FFNOUT
            if (IN(p0 + 1)) {
                pg8::Gemm g{PH, (const bf16*)(wl + (t == 0 ? OFF_W1OUT : OFF_W2OUT)), MTOK, DM, DFF}; pg8::StaticOrder S; S.init(MTOK, DM, F.G, (int)blockIdx.x, FFNOUT_REV);
                EpiResid E{XB, SS, KA::dry() ? 0.f : 0.5f};
                pg8::gemm_phase<EpiResid, pg8::StaticOrder, PG8_ALIGN, PG8_SP2, true, true>(F.lds, g, S, E, F.wave);
            }
#endif

            SEAM(p0 + 1);
        } else {
#ifndef SK_PROJ
            if (IN(p0)) {
                pg8::Gemm g{XB, (const bf16*)(wl + OFF_WIN), MTOK, DIN, DM}; pg8::StaticOrder S; S.init(MTOK, DIN, F.G, (int)blockIdx.x);
                EpiProj E{PH, SS, (const int*)KA::in(1), F.lds, {}};
                pg8::gemm_phase<EpiProj, pg8::StaticOrder, PG8_ALIGN, PG8_SP2, true>(F.lds, g, S, E, F.wave);
            }
#endif

            SEAM(p0);
            if (IN(p0 + 1)) {
                int r0 = blockIdx.x, r1 = BATCH * NHEAD, rs = F.G, l0 = blockIdx.x, l1 = BATCH * NRB, ls = F.G;
                if (F.G == 256) { const int role = (blockIdx.x >> 3) & 1, idx = ((blockIdx.x >> 4) << 3) + (blockIdx.x & 7);
                    if (role == 0) { r0 = idx; r1 = idx + 1; l0 = l1 = 0; } else { r0 = r1 = 0; l0 = 2 * idx; l1 = 2 * idx + 2; ls = 1; } }
#ifndef SK_LRU
                for (int rep = 0; rep < REP_LRU; ++rep)
                for (int u = l0; u < l1; u += ls) lru_unit3(F, args, l, u / NRB, u % NRB);
#endif
#ifndef SK_RET
                for (int rep = 0; rep < REP_RET; ++rep)
                for (int u = r0; u < r1; u += rs) ret_unit3(F, args, u / NHEAD, u % NHEAD);
#endif
            }
            SEAM(p0 + 1);
#ifndef SK_WOUT
            if (IN(p0 + 2)) {
                pg8::Gemm g{YB, (const bf16*)(wl + OFF_WOUT), MTOK, DM, DM}; pg8::StaticOrder S; S.init(MTOK, DM, F.G, (int)blockIdx.x);
                EpiResid E{XB, SS, KA::dry() ? 0.f : 1.0f};
                pg8::gemm_phase<EpiResid, pg8::StaticOrder, PG8_ALIGN, PG8_SP2>(F.lds, g, S, E, F.wave);
            }
#endif

            SEAM(p0 + 2);
        }
    }
#ifndef SK_FINAL
    if (IN(1 + 7 * DEPTH)) phase_final(F, args);
#endif

#undef IN
#undef SEAM
}

extern "C" void kernel_launch(void* const* d_in, const int* in_sizes, int n_in, void* d_out, int out_size, void* d_ws, size_t ws_size, hipStream_t stream) {
    static int grid = 0;
    if (grid == 0) {
        if (n_in != 19 || in_sizes[0] != MTOK * DM || out_size != MTOK * DM || ws_size < WS_END) {
            fprintf(stderr, "kernel_launch: unexpected shapes (n_in %d, in0 %d, out %d, ws %zu); nothing launched\n", n_in, n_in > 0 ? in_sizes[0] : -1, out_size, ws_size); grid = -1; return; }
        int dev = 0, cus = 0, per_cu = 0;
        if (hipGetDevice(&dev) != hipSuccess || hipDeviceGetAttribute(&cus, hipDeviceAttributeMultiprocessorCount, dev) != hipSuccess) { grid = -1; return; }
        if (hipFuncSetAttribute((const void*)hymba_fwd, hipFuncAttributeMaxDynamicSharedMemorySize, LDS_BYTES) != hipSuccess) { fprintf(stderr, "kernel_launch: hipFuncSetAttribute failed\n"); grid = -1; return; }
        if (hipOccupancyMaxActiveBlocksPerMultiprocessor(&per_cu, (const void*)hymba_fwd, NWAVES * 64, LDS_BYTES) != hipSuccess || per_cu < 1)
            fprintf(stderr, "kernel_launch: note: occupancy query reports %d workgroups per CU\n", per_cu);
        (void)hipGetLastError();
        grid = cus;
    }
    if (grid < 0) return;
    (void)hipMemsetAsync((char*)d_ws + WS_CTL, 0, CTL_ZERO_BYTES, stream);
    Args a{};
    for (int i = 0; i < 19; ++i) a.in[i] = d_in[i];
    a.out = (float*)d_out; a.ws = (unsigned char*)d_ws;
    constexpr int NPH = 2 + 7 * DEPTH;
#if PROBE_REP_PHASE >= 200
    for (int p = 0; p < NPH; ++p) { a.ph_lo = p; a.ph_hi = p + 1; a.mlim = 0; hipLaunchKernelGGL(hymba_fwd, dim3(grid), dim3(NWAVES * 64), LDS_BYTES, stream, a);
        if (p == 1) for (int rep = 0; rep < 4; ++rep) { a.mlim = (PROBE_REP_PHASE - 200) * 256; hipLaunchKernelGGL(hymba_fwd, dim3(grid), dim3(NWAVES * 64), LDS_BYTES, stream, a); } }
#elif PROBE_REP_PHASE >= 0
    for (int p = 0; p < NPH; ++p) for (int rep = 0; rep < ((p == PROBE_REP_PHASE || PROBE_REP_PHASE == 99) ? 2 : 1); ++rep) { a.ph_lo = p; a.ph_hi = p + 1; a.dry = ((p == PROBE_REP_PHASE || PROBE_REP_PHASE == 99) && rep == 0) ? 1 : 0; hipLaunchKernelGGL(hymba_fwd, dim3(grid), dim3(NWAVES * 64), LDS_BYTES, stream, a); }
#elif MK_PER_PHASE
    for (int p = 0; p < NPH; ++p) { a.ph_lo = p; a.ph_hi = p + 1; hipLaunchKernelGGL(hymba_fwd, dim3(grid), dim3(NWAVES * 64), LDS_BYTES, stream, a); }
#else
    a.ph_lo = 0; a.ph_hi = NPH; hipLaunchKernelGGL(hymba_fwd, dim3(grid), dim3(NWAVES * 64), LDS_BYTES, stream, a);
#endif
}
```

```cpp
#include <hip/hip_runtime.h>
#include <cstdio>
#include <cstdint>

#define PROBE_TMASK 0
#define FFNOUT_REV 1
#define RELAX_STORE_WAIT 1
#define PROBE_ST 0
#define WEIGHTS_BLOCKED 1
#define REP_EPI 1
#define REP_LRU 1
#define REP_RET 1
#define LRU_V 3
#define RET_V 3
#define RET_V2 1
#define PROBE_REP_PHASE -1
#ifndef MK_PER_PHASE
#define MK_PER_PHASE 0
#endif

__device__ __forceinline__ float shx(float v, int o, int lane) { return __builtin_bit_cast(float, __builtin_amdgcn_ds_bpermute((lane ^ o) << 2, __builtin_bit_cast(int, v))); }
__device__ __forceinline__ int hw_lane() { int l; asm volatile("v_mbcnt_lo_u32_b32 %0, -1, 0\n\tv_mbcnt_hi_u32_b32 %0, -1, %0" : "=v"(l)); return l; }
namespace pg8 {
#define PG8_LAS __attribute__((address_space(3)))
typedef unsigned short bf16_t;
typedef short bf16x8 __attribute__((ext_vector_type(8)));
typedef float f32x4 __attribute__((ext_vector_type(4)));
typedef unsigned u32x4 __attribute__((ext_vector_type(4)));
constexpr int BM = 256, BK = 64, HALF = 128, HTB = HALF * BK * 2, STAGE_BYTES = 8 * HTB, NXCD = 8, WGM = 8;

__host__ __device__ __forceinline__ int lds_byte(int r, int c) { const int st = (r >> 4) * 2 + (c >> 5), rr = r & 15, cc = c & 31, ob = rr * 64 + cc * 2; return st * 1024 + (ob ^ (((ob >> 9) & 1) << 5)); }
__host__ __device__ __forceinline__ void stage_rc(int b, int& R, int& C) { const int st = b / 1024, sb = b % 1024, swz = sb ^ (((sb >> 9) & 1) << 5); R = (st >> 1) * 16 + swz / 64; C = (st & 1) * 32 + (swz % 64) / 2; }
__host__ __device__ __forceinline__ int perm32(int rho) { const int n = rho >> 4, i = rho & 15; return 8 * (i >> 2) + 4 * n + (i & 3); }

struct Unit { int pm, pn; };
struct Gemm { const bf16_t* A; const bf16_t* Bt; int M, N, K; };

struct StaticOrder {
    int nM, nN, nwg, G, c, rev;
    __host__ __device__ void init(int M, int N, int G_, int c_, int rev_ = 0) { nM = M / BM; nN = N / BM; nwg = nM * nN; G = G_; c = c_; rev = rev_; }
    __host__ __device__ bool next(int i, Unit& u) const {
        const int rounds = (nwg + G - 1) / G; if (i >= rounds) return false;
        const long L = (long)(rev ? rounds - 1 - i : i) * G + c; if (L >= nwg) return false;
        int wgid = (int)L; { const int q = nwg / NXCD, r = nwg % NXCD, xcd = wgid % NXCD, off = wgid / NXCD; wgid = (xcd < r ? xcd * (q + 1) : r * (q + 1) + (xcd - r) * q) + off; }
        const int nig = WGM * nN, gid = wgid / nig, fm = gid * WGM, gsz = (nM - fm) < WGM ? (nM - fm) : WGM;
        u.pm = fm + ((wgid % nig) % gsz); u.pn = (wgid % nig) / gsz; return true;
    }
    __device__ __forceinline__ void a_ready(const Unit&) const {}
    __device__ __forceinline__ void done(const Unit&) const {}
};

__device__ __forceinline__ unsigned cvt_pk_bf16(float lo, float hi) { unsigned r; asm("v_cvt_pk_bf16_f32 %0, %1, %2" : "=v"(r) : "v"(lo), "v"(hi)); return r; }

template <class Epi, class Sched, bool ALIGN_EPI = false, bool SP2 = false, bool ABLK = false, bool ALIN = false>
__device__ __forceinline__ void gemm_phase(PG8_LAS unsigned char* lds, const Gemm g, const Sched& S, const Epi& E, int wave) {
    int tid = wave * 64 + hw_lane(); asm volatile("" : "+v"(tid));
    const int wid = __builtin_amdgcn_readfirstlane(tid >> 6), lane = tid & 63, wr = wid >> 2, wc = wid & 3, fr = lane & 15, fq = lane >> 4;
    const int K = g.K, nt = K / BK;
    constexpr bool BBLK_ = Epi::PERM && WEIGHTS_BLOCKED;
    unsigned voffA[2], voffB[2];
#pragma unroll
    for (int i = 0; i < 2; ++i) { int R, C; stage_rc(tid * 16 + i * 8192, R, C); const int Rb = Epi::PERM ? ((R & ~31) + perm32(R & 31)) : R;
        voffA[i] = ALIN ? (unsigned)((((tid >> 6) + 8 * i) & 1) * 16384 + (((tid >> 6) + 8 * i) >> 1) * 1024 + (tid & 63) * 16) : ABLK ? (unsigned)((C >> 5) * 16384 + R * 64 + (C & 31) * 2) : (unsigned)(R * K + C) * 2u; voffB[i] = BBLK_ ? (unsigned)((C >> 5) * 16384 + R * 64 + (C & 31) * 2) : (unsigned)(Rb * K + C) * 2u; }
    const size_t kstep = (size_t)(BK * 2);
    const size_t hstep = (size_t)HALF * K * 2;
    const size_t tstep = 2 * hstep;
    const size_t kstepB = BBLK_ ? (size_t)32768 : kstep, hstepB = BBLK_ ? (size_t)8192 : hstep;
    const size_t kstepA = ABLK ? (size_t)32768 : kstep, hstepA = ABLK ? (size_t)8192 : hstep;
    const unsigned ldsw = (unsigned)wid * 1024u;
    const int aoff = ALIN ? wr * 8192 + lane * 16 : lds_byte(wr * 64 + fr, fq * 8), boff = lds_byte(wc * 32 + fr, fq * 8);
#define PG8_SA(b, h) (((b) * 2 + (h)) * HTB)
#define PG8_SB(b, h) ((4 + (b) * 2 + (h)) * HTB)
#define PG8_STAGE(bufoff, gbase, voff) do { _Pragma("unroll") for (int _i = 0; _i < 2; ++_i) \
        __builtin_amdgcn_global_load_lds((const unsigned*)((const char*)(gbase) + (voff)[_i]), (PG8_LAS unsigned*)(lds + (bufoff) + ldsw + _i * 8192), 16, 0, 0); } while (0)
#define PG8_LDA(dst, b, h) do { _Pragma("unroll") for (int m = 0; m < 4; ++m) _Pragma("unroll") for (int k = 0; k < 2; ++k) dst[m][k] = *(const PG8_LAS bf16x8*)(lds + PG8_SA(b, h) + aoff + m * 2048 + k * 1024); } while (0)
#define PG8_LDB(dst, b, h) do { _Pragma("unroll") for (int n = 0; n < 2; ++n) _Pragma("unroll") for (int k = 0; k < 2; ++k) dst[n][k] = *(const PG8_LAS bf16x8*)(lds + PG8_SB(b, h) + boff + n * 2048 + k * 1024); } while (0)
#define PG8_MMA(ai, bj, At, Bt) do { __builtin_amdgcn_s_setprio(1); _Pragma("unroll") for (int m = 0; m < 4; ++m) _Pragma("unroll") for (int n = 0; n < 2; ++n) _Pragma("unroll") for (int k = 0; k < 2; ++k) \
        acc[ai][bj][m][n] = __builtin_amdgcn_mfma_f32_16x16x32_bf16(Bt[n][k], At[m][k], acc[ai][bj][m][n], 0, 0, 0); __builtin_amdgcn_s_setprio(0); } while (0)
#define PG8_WAIT_V(n) asm volatile("s_waitcnt vmcnt(" #n ")" ::: "memory")
#define PG8_WAIT_L(n) asm volatile("s_waitcnt lgkmcnt(" #n ")" ::: "memory")
#define PG8_WAIT_V8R(rx) asm volatile("s_cmp_eq_u32 %0, 0\n\ts_cbranch_scc0 .Lrw%=\n\ts_waitcnt vmcnt(8)\n.Lrw%=:\n\ts_waitcnt vmcnt(%1)" :: "s"(rx), "n"(8 + Epi::NSTORES) : "memory", "scc")
#define PG8_BAR __builtin_amdgcn_s_barrier()
#define PG8_SCHED __builtin_amdgcn_sched_barrier(0)
    Unit cur, nxt; int ui = 0;
    if (!S.next(0, cur)) return;
    f32x4 acc[2][2][4][2];
#pragma unroll
    for (int a = 0; a < 2; ++a)
#pragma unroll
        for (int b = 0; b < 2; ++b)
#pragma unroll
            for (int m = 0; m < 4; ++m)
#pragma unroll
                for (int n = 0; n < 2; ++n) acc[a][b][m][n] = (f32x4){0.f, 0.f, 0.f, 0.f};
    bf16x8 At[4][2], B0[2][2], B1[2][2];
    const char* cA = (const char*)g.A + (size_t)cur.pm * tstep; const char* cB = (const char*)g.Bt + (size_t)cur.pn * tstep;
    S.a_ready(cur);
    if constexpr (SP2) {
        PG8_STAGE(PG8_SB(0, 0), cB, voffB); PG8_STAGE(PG8_SB(0, 1), cB + hstepB, voffB); PG8_STAGE(PG8_SA(0, 0), cA, voffA); PG8_STAGE(PG8_SA(0, 1), cA + hstepA, voffA);
        if (wr == 1) PG8_BAR;
        PG8_WAIT_V(2); PG8_BAR;
        PG8_STAGE(PG8_SB(1, 0), cB + kstepB, voffB); PG8_STAGE(PG8_SA(1, 0), cA + kstepA, voffA); PG8_STAGE(PG8_SB(1, 1), cB + hstepB + kstepB, voffB);
        PG8_WAIT_V(6); PG8_BAR;
    } else {
        PG8_STAGE(PG8_SB(0, 0), cB, voffB); PG8_STAGE(PG8_SA(0, 0), cA, voffA); PG8_STAGE(PG8_SB(0, 1), cB + hstepB, voffB); PG8_STAGE(PG8_SA(0, 1), cA + hstepA, voffA);
        if (wr == 1) PG8_BAR;
        PG8_WAIT_V(4); PG8_BAR;
        PG8_STAGE(PG8_SB(1, 0), cB + kstepB, voffB); PG8_STAGE(PG8_SA(1, 0), cA + kstepA, voffA); PG8_STAGE(PG8_SB(1, 1), cB + hstepB + kstepB, voffB);
        PG8_WAIT_V(6); PG8_BAR;
    }
    for (;;) {
        const bool has_next = S.next(ui + 1, nxt);
        const char* nA = has_next ? (const char*)g.A + (size_t)nxt.pm * tstep : cA; const char* nB = has_next ? (const char*)g.Bt + (size_t)nxt.pn * tstep : cB;
        for (int t = 0; t < nt; t += 2) {
            const bool last = (t == nt - 2);
            const int relax = __builtin_amdgcn_readfirstlane((RELAX_STORE_WAIT && t == 0 && ui > 0) ? 1 : 0);
            const char* a1 = cA + (size_t)(t + 1) * kstepA;
            const char* a2 = last ? nA : cA + (size_t)(t + 2) * kstepA; const char* b2 = last ? nB : cB + (size_t)(t + 2) * kstepB;
            const char* a3 = a2 + kstepA; const char* b3 = b2 + kstepB;
            if (last && has_next) S.a_ready(nxt);
            if constexpr (SP2) {
            PG8_LDB(B0, 0, 0); PG8_LDB(B1, 0, 1); PG8_SCHED; PG8_LDA(At, 0, 0); PG8_STAGE(PG8_SA(1, 1), a1 + hstepA, voffA);
            PG8_WAIT_V8R(relax); PG8_WAIT_L(0); PG8_BAR; PG8_MMA(0, 0, At, B0); PG8_MMA(0, 1, At, B1); PG8_BAR; PG8_SCHED;
            PG8_LDA(At, 0, 1); PG8_STAGE(PG8_SB(0, 0), b2, voffB); PG8_STAGE(PG8_SB(0, 1), b2 + hstepB, voffB); PG8_STAGE(PG8_SA(0, 0), a2, voffA);
            PG8_WAIT_V8R(relax); PG8_WAIT_L(0); PG8_BAR; PG8_MMA(1, 0, At, B0); PG8_MMA(1, 1, At, B1); PG8_BAR; PG8_SCHED;
            PG8_LDB(B0, 1, 0); PG8_LDB(B1, 1, 1); PG8_SCHED; PG8_LDA(At, 1, 0); PG8_STAGE(PG8_SA(0, 1), a2 + hstepA, voffA);
            PG8_WAIT_V(8); PG8_WAIT_L(0); PG8_BAR; PG8_MMA(0, 0, At, B0); PG8_MMA(0, 1, At, B1); PG8_BAR; PG8_SCHED;
            PG8_LDA(At, 1, 1); PG8_STAGE(PG8_SB(1, 0), b3, voffB); PG8_STAGE(PG8_SB(1, 1), b3 + hstepB, voffB); PG8_STAGE(PG8_SA(1, 0), a3, voffA);
            PG8_WAIT_V(8); PG8_WAIT_L(0); PG8_BAR; PG8_MMA(1, 0, At, B0); PG8_MMA(1, 1, At, B1); PG8_BAR; PG8_SCHED;
            } else {
            PG8_LDB(B0, 0, 0); PG8_SCHED; PG8_LDA(At, 0, 0); PG8_STAGE(PG8_SA(1, 1), a1 + hstepA, voffA);
            PG8_WAIT_L(8); PG8_BAR; PG8_WAIT_L(0); PG8_MMA(0, 0, At, B0); PG8_BAR; PG8_SCHED;
            PG8_LDB(B1, 0, 1); PG8_STAGE(PG8_SB(0, 0), b2, voffB);
            PG8_BAR; PG8_WAIT_L(0); PG8_MMA(0, 1, At, B1); PG8_BAR;
            PG8_LDA(At, 0, 1); PG8_STAGE(PG8_SA(0, 0), a2, voffA);
            PG8_BAR; PG8_WAIT_L(0); PG8_MMA(1, 0, At, B0); PG8_BAR; PG8_SCHED;
            PG8_STAGE(PG8_SB(0, 1), b2 + hstepB, voffB);
            PG8_WAIT_V(6); PG8_BAR; PG8_MMA(1, 1, At, B1); PG8_BAR;
            PG8_LDB(B0, 1, 0); PG8_SCHED; PG8_LDA(At, 1, 0); PG8_STAGE(PG8_SA(0, 1), a2 + hstepA, voffA);
            PG8_WAIT_L(8); PG8_BAR; PG8_WAIT_L(0); PG8_MMA(0, 0, At, B0); PG8_BAR; PG8_SCHED;
            PG8_LDB(B1, 1, 1); PG8_STAGE(PG8_SB(1, 0), b3, voffB);
            PG8_BAR; PG8_WAIT_L(0); PG8_MMA(0, 1, At, B1); PG8_BAR;
            PG8_LDA(At, 1, 1); PG8_STAGE(PG8_SA(1, 0), a3, voffA);
            PG8_BAR; PG8_WAIT_L(0); PG8_MMA(1, 0, At, B0); PG8_BAR; PG8_SCHED;
            PG8_STAGE(PG8_SB(1, 1), b3 + hstepB, voffB);
            PG8_WAIT_V(6); PG8_BAR; PG8_MMA(1, 1, At, B1); PG8_BAR;
            }
        }
        if constexpr (ALIGN_EPI) { if (wr == 0) PG8_BAR; }
        static_assert(ALIGN_EPI, "the epilogues' prep() barrier needs both half-workgroups aligned");
        E.prep(cur, lds, tid);
        E(acc, cur, wr, wc, fr, fq);
#if REP_EPI > 1
        if constexpr (Epi::IDEMP) { for (int rep = 1; rep < REP_EPI; ++rep) { asm volatile("" ::: "memory"); E(acc, cur, wr, wc, fr, fq); } }
#endif
        S.done(cur);
        if (!has_next) break;
        {
            float zf = 0.f;
#pragma unroll
            for (int a = 0; a < 2; ++a)
#pragma unroll
                for (int b = 0; b < 2; ++b)
#pragma unroll
                    for (int m = 0; m < 4; ++m)
#pragma unroll
                        for (int n = 0; n < 2; ++n) { asm volatile("" : "+v"(zf)); acc[a][b][m][n] = __builtin_amdgcn_mfma_f32_4x4x1f32(zf, zf, (f32x4){0.f, 0.f, 0.f, 0.f}, 0, 0, 0); }
        }
        cur = nxt; cA = nA; cB = nB; ++ui;
        if constexpr (ALIGN_EPI) { if (wr == 1) PG8_BAR; }
    }
    PG8_WAIT_V(0);
    if constexpr (!ALIGN_EPI) { if (wr == 0) PG8_BAR; }
    PG8_BAR;
#undef PG8_SA
#undef PG8_SB
#undef PG8_STAGE
#undef PG8_LDA
#undef PG8_LDB
#undef PG8_MMA
#undef PG8_WAIT_V
#undef PG8_WAIT_V8R
#undef PG8_WAIT_L
#undef PG8_BAR
#undef PG8_SCHED
}
}

#define PG8_SP2 true
#define PG8_ALIGN true

constexpr int NWAVES = 8;
constexpr int BATCH = 32, SEQ = 2048, DM = 1024, MTOK = BATCH * SEQ, DFF = 2816, NFF = 2 * DFF, DIN = 3072;
constexpr int DRNN = 512, NRB = 8, RB = 64, NHEAD = 4, DH = 128, CHUNK = 128, NCHUNK = SEQ / CHUNK, DEPTH = 2;
constexpr float EPS = 1e-6f;

constexpr size_t MiB = 1u << 20;
constexpr size_t WS_CTL = 0, CTL_ZERO_BYTES = 32768;
constexpr size_t SZ_WFIN = (size_t)NFF * DM * 2, SZ_WFOUT = (size_t)DM * DFF * 2, SZ_WIN = (size_t)DIN * DM * 2, SZ_WOUT = (size_t)DM * DM * 2;
constexpr size_t OFF_W1IN = 0, OFF_W1OUT = OFF_W1IN + SZ_WFIN, OFF_WIN = OFF_W1OUT + SZ_WFOUT, OFF_WOUT = OFF_WIN + SZ_WIN, OFF_W2IN = OFF_WOUT + SZ_WOUT, OFF_W2OUT = OFF_W2IN + SZ_WFIN;
constexpr size_t SZ_WLAYER = OFF_W2OUT + SZ_WFOUT;
constexpr size_t WS_W = 2 * MiB;
constexpr size_t WS_XB = 96 * MiB;
constexpr size_t WS_SS = 224 * MiB;
constexpr size_t WS_Y = 232 * MiB;
constexpr size_t WS_PH = 360 * MiB;
constexpr size_t WS_END = 744 * MiB;
static_assert(WS_W + 2 * SZ_WLAYER <= WS_XB, "weights fit");
constexpr int CW_BAR = 4096;
static_assert((CW_BAR + 3456) * 4 <= (int)CTL_ZERO_BYTES, "barrier words inside the per-call memset");

constexpr int LDS_BYTES = 147456;
constexpr int MISC_OFF = LDS_BYTES - 64;

#define LAS __attribute__((address_space(3)))
typedef unsigned short bf16;
typedef unsigned v4u __attribute__((ext_vector_type(4)));
typedef unsigned v2u __attribute__((ext_vector_type(2)));
typedef float f32x4 __attribute__((ext_vector_type(4)));
typedef short bf16x8 __attribute__((ext_vector_type(8)));
typedef short bf16x4 __attribute__((ext_vector_type(4)));
#define LDS_WAIT() asm volatile("s_waitcnt lgkmcnt(0)" ::: "memory")
#define VM_WAIT() asm volatile("s_waitcnt vmcnt(0)" ::: "memory")
#define LDS_BARRIER() do { asm volatile("s_waitcnt lgkmcnt(0)" ::: "memory"); __builtin_amdgcn_s_barrier(); asm volatile("" ::: "memory"); } while (0)
__device__ __forceinline__ unsigned pk2(float lo, float hi) { unsigned r; asm("v_cvt_pk_bf16_f32 %0, %1, %2" : "=v"(r) : "v"(lo), "v"(hi)); return r; }
__device__ __forceinline__ unsigned f2bf(float f) { return pk2(f, 0.f) & 0xffffu; }
__device__ __forceinline__ float bf2f(unsigned b) { return __builtin_bit_cast(float, b << 16); }
__device__ __forceinline__ float bflo(unsigned w) { return __builtin_bit_cast(float, w << 16); }
__device__ __forceinline__ float bfhi(unsigned w) { return __builtin_bit_cast(float, w & 0xffff0000u); }

#define XB_TMO      128
#define XB_XCNT(j)  (256  + 64 * (j))
#define XB_XSUB(j)  (1280 + 64 * (j))
#define XB_XGEN(j)  (2304 + 64 * (j))
#define XB_TOP      3328
#define XB_TOPGEN   3392
#define XCD_BAR_WORDS 3456
#define XB_SPIN_CAP (1u << 18)

#define GAS __attribute__((address_space(1)))
typedef GAS unsigned gu32;
__device__ __forceinline__ unsigned xb_ld(gu32* p)              { return __hip_atomic_load(p, __ATOMIC_RELAXED, __HIP_MEMORY_SCOPE_AGENT); }
__device__ __forceinline__ unsigned xb_add(gu32* p, unsigned v) { return __hip_atomic_fetch_add(p, v, __ATOMIC_RELAXED, __HIP_MEMORY_SCOPE_AGENT); }
__device__ __forceinline__ unsigned xb_xcc_id() { return (unsigned)__builtin_amdgcn_s_getreg((3 << 11) | 20) & 0xFu; }
#define XB_SPIN(cond, bar) do { unsigned _sp = 0; while (cond) { __builtin_amdgcn_s_sleep(1); \
    if ((++_sp & 255u) == 0u) { if (xb_ld(&(bar)[XB_TMO])) break; if (_sp > XB_SPIN_CAP) { xb_add(&(bar)[XB_TMO], 1u); break; } } } } while (0)

struct XcdBarrier {
    unsigned* bar; unsigned x; bool wave0;
    volatile LAS unsigned* st;
};
__device__ __forceinline__ XcdBarrier xcd_barrier_post(unsigned* bar, volatile LAS unsigned* st, int wave) {
    XcdBarrier b; b.bar = bar; b.x = xb_xcc_id(); b.st = st; b.wave0 = (wave == 0);
    if (b.wave0 && hw_lane() == 0) (void)xb_add(&((gu32*)bar)[XB_XCNT(b.x)], 1u);
    return b;
}
__device__ __forceinline__ void xcd_barrier_complete(gu32* bar, unsigned x, unsigned& nloc, unsigned& nx) {
    const unsigned G = gridDim.x * gridDim.y * gridDim.z;
    unsigned sum, cnt, mine, sp = 0u;
    for (;;) {
        sum = 0u; cnt = 0u; mine = 0u;
#pragma unroll
        for (unsigned j = 0; j < 16; ++j) { const unsigned c = xb_ld(&bar[XB_XCNT(j)]); sum += c; cnt += (c > 0u) ? 1u : 0u; mine = (j == x) ? c : mine; }
        if (sum == G) break;
        __builtin_amdgcn_s_sleep(1);
        if ((++sp & 255u) == 0u) { if (xb_ld(&bar[XB_TMO])) break; if (sp > XB_SPIN_CAP) { xb_add(&bar[XB_TMO], 1u); break; } }
    }
    nloc = mine > 0u ? mine : 1u; nx = cnt > 0u ? cnt : 1u;
}
__device__ __forceinline__ void xcd_barrier(const XcdBarrier& b) {
    asm volatile("s_waitcnt vmcnt(0)" ::: "memory");
    __syncthreads();
    if (b.wave0 && hw_lane() == 0) {
        unsigned* bar0 = b.bar; asm volatile("" : "+s"(bar0));
        gu32* bar = (gu32*)bar0;
        __builtin_amdgcn_s_waitcnt(0);
        unsigned nloc = b.st[0], nx = b.st[1];
        if (nloc == 0u) { xcd_barrier_complete(bar, b.x, nloc, nx); b.st[0] = nloc; b.st[1] = nx; }
        const unsigned old = xb_add(&bar[XB_XSUB(b.x)], 1u);
        const unsigned gen = old / nloc;
        if (old + 1u == (gen + 1u) * nloc) {
            __builtin_amdgcn_fence(__ATOMIC_RELEASE, "agent");
            asm volatile("s_waitcnt vmcnt(0)" ::: "memory");
            const unsigned og = xb_add(&bar[XB_TOP], 1u);
            const unsigned tg = og / nx;
            if (og + 1u == (tg + 1u) * nx) xb_add(&bar[XB_TOPGEN], 1u);
            else XB_SPIN(xb_ld(&bar[XB_TOPGEN]) == tg, bar);
            __builtin_amdgcn_fence(__ATOMIC_ACQUIRE, "agent");
            xb_add(&bar[XB_XGEN(b.x)], 1u);
            asm volatile("s_waitcnt vmcnt(0)" ::: "memory");
        } else {
            XB_SPIN(xb_ld(&bar[XB_XGEN(b.x)]) == gen, bar);
            __builtin_amdgcn_fence(__ATOMIC_ACQUIRE, "agent");
            asm volatile("s_waitcnt vmcnt(0)" ::: "memory");
        }
    }
    __syncthreads();
}

__device__ __forceinline__ size_t xb_off(int row, int c) { return (size_t)(row >> 8) * (256 * DM) + (size_t)(c >> 5) * 8192 + (row & 255) * 32 + (c & 31); }
__device__ __forceinline__ float row_scale(const float* ss, int row) {
    const f32x4* p = (const f32x4*)(ss + (size_t)row * 16);
    const f32x4 a = p[0], b = p[1], c = p[2], d = p[3];
    const float s = ((a[0] + a[1]) + (a[2] + a[3])) + ((b[0] + b[1]) + (b[2] + b[3])) + ((c[0] + c[1]) + (c[2] + c[3])) + ((d[0] + d[1]) + (d[2] + d[3]));
    return rsqrtf(s * (1.0f / DM) + EPS);
}
__device__ __forceinline__ float sigmoid_f(float v) { return __builtin_amdgcn_rcpf(1.0f + __builtin_amdgcn_exp2f(-1.44269504f * v)); }
__device__ __forceinline__ float silu_f(float v) { return v * sigmoid_f(v); }
__device__ __forceinline__ float gelu_tanh_f(float v) { const float z = 1.5957691216f * (v + 0.044715f * v * v * v); return v * sigmoid_f(z); }

constexpr int RST_OFF = 131072;
struct RowScaleCache {
    mutable int cached_pm = -1;
    __device__ __forceinline__ void prep(const float* ss, const pg8::Unit& u, PG8_LAS unsigned char* lds, int tid, const int* pos = nullptr) const {
        if (u.pm != cached_pm) {
            if (tid < 256) { ((PG8_LAS float*)(lds + RST_OFF))[tid] = row_scale(ss, u.pm * 256 + tid);
                if (pos) ((PG8_LAS float*)(lds + RST_OFF + 1024))[tid] = (float)pos[u.pm * 256 + tid]; }
            asm volatile("s_waitcnt lgkmcnt(0)" ::: "memory"); __builtin_amdgcn_s_barrier(); asm volatile("" ::: "memory");
            cached_pm = u.pm;
        }
    }
    static __device__ __forceinline__ float get(PG8_LAS unsigned char* lds, int r) { return ((const PG8_LAS float*)(lds + RST_OFF))[r]; }
};
struct EpiSwiGLU {
    static constexpr bool PERM = true, AFTER_DRAIN = false, IDEMP = true; static constexpr int NSTORES = 8;
    pg8::bf16_t* H; const float* ss; PG8_LAS unsigned char* lds; RowScaleCache rc;
    __device__ __forceinline__ void prep(const pg8::Unit& u, PG8_LAS unsigned char* l, int tid) const { rc.prep(ss, u, l, tid); }
    __device__ __forceinline__ void operator()(const pg8::f32x4 (&acc)[2][2][4][2], const pg8::Unit& u, int wr, int wc, int fr, int fq) const {
        const int row0 = u.pm * 256 + wr * 64 + fr, col0 = u.pn * 128 + wc * 32 + 8 * fq;
#pragma unroll
        for (int ai = 0; ai < 2; ++ai)
#pragma unroll
            for (int m = 0; m < 4; ++m) {
                const int row = row0 + ai * 128 + m * 16; const float rs = RowScaleCache::get(lds, row & 255);
                typedef float f32x2 __attribute__((ext_vector_type(2)));
                const float c1 = -1.44269504f * rs, rs2 = rs * rs;
                f32x2 gr[4], ur[4], t[4], o2[4];
#pragma unroll
                for (int n = 0; n < 2; ++n)
#pragma unroll
                    for (int i = 0; i < 2; ++i) { gr[n * 2 + i] = (f32x2){acc[ai][0][m][n][2 * i], acc[ai][0][m][n][2 * i + 1]}; ur[n * 2 + i] = (f32x2){acc[ai][1][m][n][2 * i], acc[ai][1][m][n][2 * i + 1]}; }
#pragma unroll
                for (int j = 0; j < 4; ++j) t[j] = gr[j] * c1;
#pragma unroll
                for (int j = 0; j < 4; ++j) t[j] = (f32x2){__builtin_amdgcn_exp2f(t[j].x), __builtin_amdgcn_exp2f(t[j].y)};
#pragma unroll
                for (int j = 0; j < 4; ++j) { t[j] = t[j] + 1.0f; o2[j] = gr[j] * ur[j]; }
#pragma unroll
                for (int j = 0; j < 4; ++j) t[j] = (f32x2){__builtin_amdgcn_rcpf(t[j].x), __builtin_amdgcn_rcpf(t[j].y)};
#pragma unroll
                for (int j = 0; j < 4; ++j) o2[j] = (o2[j] * rs2) * t[j];
                float o[8];
#pragma unroll
                for (int j = 0; j < 4; ++j) { o[2 * j] = o2[j].x; o[2 * j + 1] = o2[j].y; }
                pg8::u32x4 w; w.x = pg8::cvt_pk_bf16(o[0], o[1]); w.y = pg8::cvt_pk_bf16(o[2], o[3]); w.z = pg8::cvt_pk_bf16(o[4], o[5]); w.w = pg8::cvt_pk_bf16(o[6], o[7]);
                *(pg8::u32x4*)(H + (size_t)u.pm * (256 * DFF) + (size_t)(4 * u.pn + wc) * 8192 + ((row & 255) >> 4) * 512 + fq * 128 + (row & 15) * 8) = w;
#if PROBE_ST == 1
                *(pg8::u32x4*)((char*)H + (size_t)(768u << 20) - (size_t)(360u << 20) + ((((size_t)row * DFF + col0) * 2) & ((256u << 20) - 1))) = w;
#elif PROBE_ST == 2
                *(pg8::u32x4*)((char*)H + (size_t)(768u << 20) - (size_t)(360u << 20) + (((((size_t)(u.pm * 22 + u.pn) * 8 + wr * 4 + wc) * 8 + ai * 4 + m) * 1024 + (fr + 16 * fq) * 16) & ((256u << 20) - 1))) = w;
#endif
            }
    }
};
struct EpiResid {
    static constexpr bool PERM = true, AFTER_DRAIN = false, IDEMP = false; static constexpr int NSTORES = 24;
    pg8::bf16_t* xb; float* ss; float alpha;
    __device__ __forceinline__ void prep(const pg8::Unit&, PG8_LAS unsigned char*, int) const {}
    static __device__ __forceinline__ float row_out(pg8::bf16_t* dst, const pg8::f32x4& o0, const pg8::f32x4& o1, const pg8::f32x4& a0, const pg8::f32x4& a1, float alpha) {
        const pg8::f32x4 v0 = o0 + a0 * alpha, v1 = o1 + a1 * alpha;
        pg8::u32x4 w; w.x = pg8::cvt_pk_bf16(v0[0], v0[1]); w.y = pg8::cvt_pk_bf16(v0[2], v0[3]); w.z = pg8::cvt_pk_bf16(v1[0], v1[1]); w.w = pg8::cvt_pk_bf16(v1[2], v1[3]);
        *(pg8::u32x4*)dst = w;
        const pg8::f32x4 qq = v0 * v0 + v1 * v1;
        return (qq[0] + qq[1]) + (qq[2] + qq[3]);
    }
    __device__ __forceinline__ void operator()(const pg8::f32x4 (&acc)[2][2][4][2], const pg8::Unit& u, int wr, int wc, int fr, int fq) const {
        const int row0 = u.pm * 256 + wr * 64 + fr, col0 = u.pn * 256 + wc * 32 + 8 * fq, ln = fq * 16 + fr;
#pragma unroll
        for (int ai = 0; ai < 2; ++ai) {
            pg8::u32x4 xw[4][2];
#pragma unroll
            for (int m = 0; m < 4; ++m)
#pragma unroll
                for (int bj = 0; bj < 2; ++bj) xw[m][bj] = *(const pg8::u32x4*)(xb + xb_off(row0 + ai * 128 + m * 16, col0 + bj * 128));
            float sq[4];
#pragma unroll
            for (int m = 0; m < 4; ++m) { sq[m] = 0.f;
#pragma unroll
                for (int bj = 0; bj < 2; ++bj) { const pg8::u32x4 w = xw[m][bj];
                    const pg8::f32x4 o0 = (pg8::f32x4){bflo(w.x), bfhi(w.x), bflo(w.y), bfhi(w.y)}, o1 = (pg8::f32x4){bflo(w.z), bfhi(w.z), bflo(w.w), bfhi(w.w)};
                    sq[m] += row_out(xb + xb_off(row0 + ai * 128 + m * 16, col0 + bj * 128), o0, o1, acc[ai][bj][m][0], acc[ai][bj][m][1], alpha); } }
#pragma unroll
            for (int m = 0; m < 4; ++m) { sq[m] += shx(sq[m], 16, ln); }
#pragma unroll
            for (int m = 0; m < 4; ++m) { sq[m] += shx(sq[m], 32, ln); }
#pragma unroll
            for (int m = 0; m < 4; ++m) if (fq == 0) ss[(size_t)(row0 + ai * 128 + m * 16) * 16 + 4 * u.pn + wc] = sq[m];
        }
    }
};
constexpr size_t PREG = (size_t)MTOK * 512;
__device__ __forceinline__ size_t ph_addr(int row, int c) {
    const int r = c >> 9, cc = c & 511, b = row >> 11, sq = row & (SEQ - 1);
    return r < 2 ? (size_t)r * PREG + ((size_t)(((b * NRB + (cc >> 6)) * 2 + ((cc >> 5) & 1)) * SEQ + sq) << 5) + (cc & 31)
                 : (size_t)r * PREG + ((size_t)(((b * NHEAD + (cc >> 7)) * 4 + ((cc >> 5) & 3)) * SEQ + sq) << 5) + (cc & 31);
}
struct EpiProj {
    static constexpr bool PERM = true, AFTER_DRAIN = false, IDEMP = true; static constexpr int NSTORES = 16;
    pg8::bf16_t* P; const float* ss; const int* pos; PG8_LAS unsigned char* lds; RowScaleCache rc;
    __device__ __forceinline__ void prep(const pg8::Unit& u, PG8_LAS unsigned char* l, int tid) const { rc.prep(ss, u, l, tid, pos); }
    __device__ __forceinline__ void operator()(const pg8::f32x4 (&acc)[2][2][4][2], const pg8::Unit& u, int wr, int wc, int fr, int fq) const {
        const int row0 = u.pm * 256 + wr * 64 + fr; const int pn = u.pn;
        if (pn >= 4 && pn < 8) {
            const int jj0 = 32 * (wc & 1) + 8 * fq; const float ksc = (pn >= 6) ? 0.08838834764831845f : 1.0f;
            float inv[8];
#pragma unroll
            for (int j = 0; j < 8; ++j) inv[j] = __builtin_amdgcn_exp2f(-(float)(jj0 + j) * 0.20762050593046014f) * 0.15915494309189535f;
            const int cbase = 256 * pn + 128 * (wc >> 1) + jj0;
            const float dsl = ((pn >= 6) ? -1.0f : 1.0f) * __builtin_amdgcn_logf(1.0f - __builtin_amdgcn_exp2f(-5.0f - (float)(2 * (pn & 1) + (wc >> 1))));
            float pv[2][4];
#pragma unroll
            for (int ai = 0; ai < 2; ++ai)
#pragma unroll
                for (int m = 0; m < 4; ++m) pv[ai][m] = ((const PG8_LAS float*)(lds + RST_OFF + 1024))[(row0 + ai * 128 + m * 16) & 255];
#pragma unroll
            for (int ai = 0; ai < 2; ++ai)
#pragma unroll
                for (int m = 0; m < 4; ++m) {
                    const int row = row0 + ai * 128 + m * 16; const float p = pv[ai][m];
                    const float rs = RowScaleCache::get(lds, row & 255) * ksc * __builtin_amdgcn_exp2f((float)(row & (CHUNK - 1)) * dsl);
                    typedef float f32x2 __attribute__((ext_vector_type(2)));
                    f32x2 rev[4], sn[4], cs[4], t1[4], t2[4], q1[4], q2[4];
#pragma unroll
                    for (int j = 0; j < 4; ++j) rev[j] = (f32x2){inv[2 * j], inv[2 * j + 1]} * p;
#pragma unroll
                    for (int j = 0; j < 4; ++j) rev[j] = (f32x2){__builtin_amdgcn_fractf(rev[j].x), __builtin_amdgcn_fractf(rev[j].y)};
#pragma unroll
                    for (int j = 0; j < 4; ++j) sn[j] = (f32x2){__builtin_amdgcn_sinf(rev[j].x), __builtin_amdgcn_sinf(rev[j].y)};
#pragma unroll
                    for (int j = 0; j < 4; ++j) cs[j] = (f32x2){__builtin_amdgcn_cosf(rev[j].x), __builtin_amdgcn_cosf(rev[j].y)};
#pragma unroll
                    for (int n = 0; n < 2; ++n)
#pragma unroll
                        for (int i = 0; i < 2; ++i) { t1[n * 2 + i] = (f32x2){acc[ai][0][m][n][2 * i], acc[ai][0][m][n][2 * i + 1]} * rs; t2[n * 2 + i] = (f32x2){acc[ai][1][m][n][2 * i], acc[ai][1][m][n][2 * i + 1]} * rs; }
#pragma unroll
                    for (int j = 0; j < 4; ++j) { q1[j] = t1[j] * cs[j] - t2[j] * sn[j]; q2[j] = t1[j] * sn[j] + t2[j] * cs[j]; }
                    float o1[8], o2[8];
#pragma unroll
                    for (int j = 0; j < 4; ++j) { o1[2 * j] = q1[j].x; o1[2 * j + 1] = q1[j].y; o2[2 * j] = q2[j].x; o2[2 * j + 1] = q2[j].y; }
                    pg8::u32x4 w1, w2;
                    w1.x = pg8::cvt_pk_bf16(o1[0], o1[1]); w1.y = pg8::cvt_pk_bf16(o1[2], o1[3]); w1.z = pg8::cvt_pk_bf16(o1[4], o1[5]); w1.w = pg8::cvt_pk_bf16(o1[6], o1[7]);
                    w2.x = pg8::cvt_pk_bf16(o2[0], o2[1]); w2.y = pg8::cvt_pk_bf16(o2[2], o2[3]); w2.z = pg8::cvt_pk_bf16(o2[4], o2[5]); w2.w = pg8::cvt_pk_bf16(o2[6], o2[7]);
                    *(pg8::u32x4*)(P + ph_addr(row, cbase)) = w1; *(pg8::u32x4*)(P + ph_addr(row, cbase + 64)) = w2;
                }
        } else {
            const int act = (pn == 2 || pn == 3) ? 1 : (pn >= 10 ? 2 : 0);
            const int col0 = pn * 256 + wc * 32 + 8 * fq;
#pragma unroll
            for (int ai = 0; ai < 2; ++ai)
#pragma unroll
                for (int m = 0; m < 4; ++m) {
                    const int row = row0 + ai * 128 + m * 16; const float rs = RowScaleCache::get(lds, row & 255);
#pragma unroll
                    for (int bj = 0; bj < 2; ++bj) {
                        typedef float f32x2 __attribute__((ext_vector_type(2)));
                        f32x2 v2[4], z2[4];
#pragma unroll
                        for (int n = 0; n < 2; ++n)
#pragma unroll
                            for (int i = 0; i < 2; ++i) v2[n * 2 + i] = (f32x2){acc[ai][bj][m][n][2 * i], acc[ai][bj][m][n][2 * i + 1]} * rs;
                        if (act != 0) {
                            if (act == 1) {
#pragma unroll
                                for (int j = 0; j < 4; ++j) z2[j] = v2[j] * v2[j];
#pragma unroll
                                for (int j = 0; j < 4; ++j) z2[j] = z2[j] * (0.044715f * -2.302208198f) + (-2.302208198f);
#pragma unroll
                                for (int j = 0; j < 4; ++j) z2[j] = z2[j] * v2[j];
                            } else {
#pragma unroll
                                for (int j = 0; j < 4; ++j) z2[j] = v2[j] * -1.44269504f;
                            }
#pragma unroll
                            for (int j = 0; j < 4; ++j) z2[j] = (f32x2){__builtin_amdgcn_exp2f(z2[j].x), __builtin_amdgcn_exp2f(z2[j].y)};
#pragma unroll
                            for (int j = 0; j < 4; ++j) z2[j] = z2[j] + 1.0f;
#pragma unroll
                            for (int j = 0; j < 4; ++j) z2[j] = (f32x2){__builtin_amdgcn_rcpf(z2[j].x), __builtin_amdgcn_rcpf(z2[j].y)};
#pragma unroll
                            for (int j = 0; j < 4; ++j) v2[j] = v2[j] * z2[j];
                        }
                        float v[8];
#pragma unroll
                        for (int j = 0; j < 4; ++j) { v[2 * j] = v2[j].x; v[2 * j + 1] = v2[j].y; }
                        pg8::u32x4 w; w.x = pg8::cvt_pk_bf16(v[0], v[1]); w.y = pg8::cvt_pk_bf16(v[2], v[3]); w.z = pg8::cvt_pk_bf16(v[4], v[5]); w.w = pg8::cvt_pk_bf16(v[6], v[7]);
                        *(pg8::u32x4*)(P + ph_addr(row, col0 + bj * 128)) = w;
                    }
                }
        }
    }
};

struct Args { const void* in[19]; float* out; unsigned char* ws; int ph_lo, ph_hi, dry, mlim; };
static_assert(sizeof(Args) == 184 && __builtin_offsetof(Args, out) == 152 && __builtin_offsetof(Args, ws) == 160 && __builtin_offsetof(Args, ph_lo) == 168 && __builtin_offsetof(Args, dry) == 176, "KA offsets");
#define CAS __attribute__((address_space(4)))
struct KA {
    static __device__ __forceinline__ const CAS char* base() { const CAS char* kp = (const CAS char*)__builtin_amdgcn_kernarg_segment_ptr(); asm volatile("" : "+s"(kp)); return kp; }
    static __device__ __forceinline__ const void* in(int k) { return *(const void* const CAS*)(base() + 8 * k); }
    static __device__ __forceinline__ float* out() { return *(float* const CAS*)(base() + 152); }
    static __device__ __forceinline__ unsigned char* ws() { return *(unsigned char* const CAS*)(base() + 160); }
    static __device__ __forceinline__ int lo() { return *(const CAS int*)(base() + 168); }
    static __device__ __forceinline__ int hi() { return *(const CAS int*)(base() + 172); }
    static __device__ __forceinline__ int dry() { return *(const CAS int*)(base() + 176); }
    static __device__ __forceinline__ int mlim() { return *(const CAS int*)(base() + 180); }
};
struct Frame {
    LAS unsigned char* lds;
    int wave, G;
    __device__ __forceinline__ int lane_() const { int l = hw_lane(); asm volatile("" : "+v"(l)); return l; }
    __device__ __forceinline__ int tid_() const { int l = hw_lane(); asm volatile("" : "+v"(l)); return wave * 64 + l; }
};
__device__ __forceinline__ float wave_sum(float v, int lane) {
#pragma unroll
    for (int o = 1; o < 64; o <<= 1) v += shx(v, o, lane);
    return v;
}

__device__ __forceinline__ void transpose_item(const float* W, int K, int Nsrc, const float* gain, bf16* WT, int k0, int ndst0, int nsrc0, LAS float* scr, int lane) {
    const int rl = lane >> 3, sg = lane & 7;
    f32x4 v[8]; float gk[8];
#pragma unroll
    for (int i = 0; i < 8; ++i) { const int kk = 8 * i + rl; v[i] = *(const f32x4*)(W + (size_t)(k0 + kk) * Nsrc + nsrc0 + 4 * sg); gk[i] = gain ? gain[k0 + kk] : 1.0f; }
#pragma unroll
    for (int i = 0; i < 8; ++i) { const int kk = 8 * i + rl; LAS float* d = scr + kk * 33 + 4 * sg;
        d[0] = v[i][0] * gk[i]; d[1] = v[i][1] * gk[i]; d[2] = v[i][2] * gk[i]; d[3] = v[i][3] * gk[i]; }
    LDS_WAIT(); asm volatile("" ::: "memory");
    const int c = lane & 7;
#pragma unroll
    for (int j = 0; j < 4; ++j) { const int n = (lane >> 3) + 8 * j; const LAS float* s = scr + (8 * c) * 33 + n;
        v4u o; o.x = pk2(s[0 * 33], s[1 * 33]); o.y = pk2(s[2 * 33], s[3 * 33]); o.z = pk2(s[4 * 33], s[5 * 33]); o.w = pk2(s[6 * 33], s[7 * 33]);
#if WEIGHTS_BLOCKED
        const int nd = ndst0 + 16 * ((n >> 2) & 1) + 4 * (n >> 3) + (n & 3);
        *(v4u*)(WT + (size_t)(nd >> 8) * (256 * (size_t)K) + (size_t)((k0 >> 5) + (c >> 2)) * 8192 + (nd & 255) * 32 + 8 * (c & 3)) = o; }
#else
        *(v4u*)(WT + (size_t)(ndst0 + n) * K + k0 + 8 * c) = o; }
#endif
    LDS_WAIT(); asm volatile("" ::: "memory");
}
__device__ __forceinline__ int map_ffn(int n) { const int pn = n >> 8, bj = (n >> 7) & 1, c = n & 127; return bj * DFF + 128 * pn + c; }
__device__ __forceinline__ int map_proj(int n) { const int pn = n >> 8; if (pn < 4 || pn >= 8) return n; const int bj = (n >> 7) & 1, cc = n & 127; return 256 * pn + 128 * (cc >> 6) + 64 * bj + (cc & 63); }

__device__ __forceinline__ void phase_prep(const Frame& F, const Args& a) {
    LAS float* scr = (LAS float*)(F.lds + F.wave * 16384);
    const int gw = blockIdx.x * NWAVES + F.wave, NGW = F.G * NWAVES;
    constexpr int I_FIN = (DM / 64) * (NFF / 32), I_FOUT = (DFF / 64) * (DM / 32), I_IN = (DM / 64) * (DIN / 32), I_OUT = (DM / 64) * (DM / 32);
    constexpr int I_LAYER = 2 * I_FIN + 2 * I_FOUT + I_IN + I_OUT;
    for (int it = gw; it < DEPTH * I_LAYER; it += NGW) {
        const int l = it / I_LAYER; int r = it % I_LAYER;
        unsigned char* wl = KA::ws() + WS_W + (size_t)l * SZ_WLAYER;
        const float* W; const float* gain; bf16* WT; int K, N, mode;
        if (r < I_FIN) { W = (const float*)KA::in(3) + (size_t)l * DM * NFF; gain = (const float*)KA::in(2) + l * DM; WT = (bf16*)(wl + OFF_W1IN); K = DM; N = NFF; mode = 1; }
        else if ((r -= I_FIN) < I_FOUT) { W = (const float*)KA::in(4) + (size_t)l * DFF * DM; gain = nullptr; WT = (bf16*)(wl + OFF_W1OUT); K = DFF; N = DM; mode = 0; }
        else if ((r -= I_FOUT) < I_IN) { W = (const float*)KA::in(6) + (size_t)l * DM * DIN; gain = (const float*)KA::in(5) + l * DM; WT = (bf16*)(wl + OFF_WIN); K = DM; N = DIN; mode = 2; }
        else if ((r -= I_IN) < I_OUT) { W = (const float*)KA::in(14) + (size_t)l * DM * DM; gain = nullptr; WT = (bf16*)(wl + OFF_WOUT); K = DM; N = DM; mode = 0; }
        else if ((r -= I_OUT) < I_FIN) { W = (const float*)KA::in(16) + (size_t)l * DM * NFF; gain = (const float*)KA::in(15) + l * DM; WT = (bf16*)(wl + OFF_W2IN); K = DM; N = NFF; mode = 1; }
        else { r -= I_FIN; W = (const float*)KA::in(17) + (size_t)l * DFF * DM; gain = nullptr; WT = (bf16*)(wl + OFF_W2OUT); K = DFF; N = DM; mode = 0; }
        const int nblk = N / 32, kb = r / nblk, nb = r % nblk, n0 = 32 * nb;
        const int ns0 = mode == 1 ? map_ffn(n0) : (mode == 2 ? map_proj(n0) : n0);
        transpose_item(W, K, N, gain, WT, 64 * kb, n0, ns0, scr, F.lane_());
    }
    const float* x = (const float*)KA::in(0); bf16* xb = (bf16*)(KA::ws() + WS_XB); float* ss = (float*)(KA::ws() + WS_SS);
    for (int m2 = gw; m2 < MTOK / 2; m2 += NGW) {
        const int m = 2 * m2; const int lane = F.lane_(); f32x4 v[2][4]; float s[2];
#pragma unroll
        for (int r = 0; r < 2; ++r) { const f32x4* xr = (const f32x4*)(x + (size_t)(m + r) * DM) + lane;
#pragma unroll
            for (int j = 0; j < 4; ++j) v[r][j] = xr[64 * j]; }
#pragma unroll
        for (int r = 0; r < 2; ++r) { s[r] = 0.f;
#pragma unroll
            for (int j = 0; j < 4; ++j) s[r] += (v[r][j][0] * v[r][j][0] + v[r][j][1] * v[r][j][1]) + (v[r][j][2] * v[r][j][2] + v[r][j][3] * v[r][j][3]); }
#pragma unroll
        for (int o = 1; o < 64; o <<= 1) { s[0] += shx(s[0], o, lane); s[1] += shx(s[1], o, lane); }
#pragma unroll
        for (int r = 0; r < 2; ++r) {
#pragma unroll
            for (int j = 0; j < 4; ++j) { v2u w; w.x = pk2(v[r][j][0], v[r][j][1]); w.y = pk2(v[r][j][2], v[r][j][3]); *(v2u*)(xb + xb_off(m + r, 4 * lane + 256 * j)) = w; }
            if (lane < 16) ss[(size_t)(m + r) * 16 + lane] = lane == 0 ? s[r] : 0.f; }
    }
}
__device__ __forceinline__ void phase_final(const Frame& F, const Args& a) {
    const int gw = blockIdx.x * NWAVES + F.wave, NGW = F.G * NWAVES;
    const bf16* xb = (const bf16*)(KA::ws() + WS_XB); float* out = KA::out();
    const f32x4* gp = (const f32x4*)KA::in(18) + F.lane_(); f32x4 gn[4];
#pragma unroll
    for (int k = 0; k < 4; ++k) gn[k] = gp[64 * k];
    for (int m4 = gw; m4 < MTOK / 4; m4 += NGW) {
        const int m = 4 * m4; const int lane = F.lane_(); v2u w[4][4]; float s[4];
#pragma unroll
        for (int r = 0; r < 4; ++r)
#pragma unroll
            for (int k = 0; k < 4; ++k) w[r][k] = *(const v2u*)(xb + xb_off(m + r, 4 * lane + 256 * k));
#pragma unroll
        for (int r = 0; r < 4; ++r) { s[r] = 0.f;
#pragma unroll
            for (int k = 0; k < 4; ++k) { const v2u q = w[r][k]; const float a0 = bflo(q.x), a1 = bfhi(q.x), a2 = bflo(q.y), a3 = bfhi(q.y);
                s[r] += (a0 * a0 + a1 * a1) + (a2 * a2 + a3 * a3); } }
#pragma unroll
        for (int o = 1; o < 64; o <<= 1) {
#pragma unroll
            for (int r = 0; r < 4; ++r) s[r] += shx(s[r], o, lane); }
#pragma unroll
        for (int r = 0; r < 4; ++r) {
            float rs = rsqrtf(s[r] * (1.0f / DM) + EPS);
#if PROBE_TMASK
            rs *= 1.0f + sqrtf((float)__hip_atomic_load((unsigned*)(KA::ws() + WS_CTL) + 64, __ATOMIC_RELAXED, __HIP_MEMORY_SCOPE_AGENT) * 1e-5f);
#endif
            f32x4* orow = (f32x4*)(out + (size_t)(m + r) * DM) + lane;
#pragma unroll
            for (int k = 0; k < 4; ++k) { const v2u q = w[r][k]; orow[64 * k] = (f32x4){bflo(q.x), bfhi(q.x), bflo(q.y), bfhi(q.y)} * rs * gn[k]; }
        }
    }
}

constexpr int L_WA = 0, L_WX = 9216, L_RAW = 18432, L_XCB = 35200, L_XCF = 53632, L_AA = 86400, L_CAR = 119168, L_END = 123264;
static_assert(L_END <= MISC_OFF, "lru lds");
__device__ __forceinline__ void lru_unit3(const Frame& F, const Args& a, int layer, int b, int j) {
    LAS unsigned char* lds = F.lds;
    const bf16* XR = (const bf16*)(KA::ws() + WS_PH) + (size_t)(b * NRB + j) * SEQ * 64;
    const bf16* GT = XR + PREG;
    bf16* Y = (bf16*)(KA::ws() + WS_Y);
    const float* gaw = (const float*)KA::in(9) + ((size_t)layer * NRB + j) * RB * RB; const float* gxw = (const float*)KA::in(11) + ((size_t)layer * NRB + j) * RB * RB;
    const float* gab = (const float*)KA::in(10) + layer * DRNN + j * RB; const float* gxb = (const float*)KA::in(12) + layer * DRNN + j * RB;
    const float* lam = (const float*)KA::in(13) + layer * DRNN + j * RB;
    const float* cw = (const float*)KA::in(7) + (size_t)layer * 4 * DRNN + j * RB; const float* cb = (const float*)KA::in(8) + layer * DRNN + j * RB;
    const int w = F.wave;
    const int tid0 = F.tid_(), lane0 = tid0 & 63, col0 = lane0 & 15, q0 = lane0 >> 4;
    LDS_BARRIER();
#pragma unroll
    for (int r = 0; r < 8; ++r) { const int e = tid0 + 512 * r, i = e >> 6, o = e & 63;
        ((LAS bf16*)(lds + L_WA))[o * 72 + i] = (bf16)f2bf(-1.44269504f * gaw[e]); ((LAS bf16*)(lds + L_WX))[o * 72 + i] = (bf16)f2bf(-1.44269504f * gxw[e]); }
    float cwk[4];
#pragma unroll
    for (int k = 0; k < 4; ++k) cwk[k] = cw[k * DRNN + lane0];
    const float cbias = cb[lane0];
    float ba[4], bx[4], cl[4];
#pragma unroll
    for (int ob = 0; ob < 4; ++ob) { const int o = 16 * ob + col0; ba[ob] = -1.44269504f * gab[o]; bx[ob] = -1.44269504f * gxb[o];
        const float nl = -lam[o]; const float sp = (nl > 20.f) ? nl : log1pf(__expf(nl));
        cl[ob] = -8.0f * sp * 1.44269504f; }
    LDS_BARRIER();
    bf16x8 wfa[4][2], wfx[4][2];
#pragma unroll
    for (int ob = 0; ob < 4; ++ob)
#pragma unroll
        for (int s = 0; s < 2; ++s) { wfa[ob][s] = *(const LAS bf16x8*)(lds + L_WA + ((16 * ob + col0) * 72 + 32 * s + 8 * q0) * 2); wfx[ob][s] = *(const LAS bf16x8*)(lds + L_WX + ((16 * ob + col0) * 72 + 32 * s + 8 * q0) * 2); }
    float hcar = 0.f;
    const v4u* rpx = (const v4u*)XR + tid0; const v4u* rpg = (const v4u*)GT + tid0;
    v4u rawp[2], gtp[2];
    constexpr int CB = SEQ * 4;
    rawp[0] = rpx[0]; rawp[1] = rpx[CB]; gtp[0] = rpg[0]; gtp[1] = rpg[CB];
    for (int step = 0; step < SEQ / 128; ++step) {
        const int t0 = step * 128;
        const int tid = F.tid_(), lane = tid & 63, col = lane & 15, q = lane >> 4;
        LAS unsigned char* gt = lds + L_AA + 16384 * (step & 1);
        {
            const int pr = tid >> 2, ps = (tid & 3) * 16;
            if (tid >= 500) { const int hr = pr - 125;
                v4u h0 = (v4u){0u, 0u, 0u, 0u}, h1 = h0; if (step > 0) { h0 = *(const LAS v4u*)(lds + L_RAW + (128 + hr) * 128 + ps); h1 = *(const LAS v4u*)(lds + L_RAW + (128 + hr) * 128 + 64 + ps); }
                *(LAS v4u*)(lds + L_RAW + hr * 128 + ps) = h0; *(LAS v4u*)(lds + L_RAW + hr * 128 + 64 + ps) = h1; }
            *(LAS v4u*)(lds + L_RAW + (3 + pr) * 128 + ps) = rawp[0]; *(LAS v4u*)(lds + L_RAW + (3 + pr) * 128 + 64 + ps) = rawp[1];
            *(LAS v4u*)(gt + pr * 128 + ps) = gtp[0]; *(LAS v4u*)(gt + pr * 128 + 64 + ps) = gtp[1];
            const int adv = (step + 1 < SEQ / 128 ? step + 1 : step) * 512;
            rawp[0] = rpx[adv]; rawp[1] = rpx[adv + CB]; gtp[0] = rpg[adv]; gtp[1] = rpg[adv + CB];
        }
        LDS_BARRIER();
        if (step > 0) {
#pragma unroll
            for (int r = 0; r < 2; ++r) { const int p = tid + 512 * r, row = p >> 3, seg = p & 7;
                *(v4u*)(Y + (size_t)(b * SEQ + t0 - 128 + row) * DM + j * RB + 8 * seg) = *(const LAS v4u*)(lds + L_AA + 16384 * ((step - 1) & 1) + row * 128 + seg * 16); }
        }
        {
            float rw[19];
#pragma unroll
            for (int i = 0; i < 19; ++i) rw[i] = bf2f(((const LAS bf16*)(lds + L_RAW))[(16 * w + i) * 64 + lane]);
            float xcv[16];
#pragma unroll
            for (int r = 0; r < 16; ++r) xcv[r] = cbias + cwk[0] * rw[r] + cwk[1] * rw[r + 1] + cwk[2] * rw[r + 2] + cwk[3] * rw[r + 3];
#pragma unroll
            for (int r = 0; r < 16; ++r) { ((LAS float*)(lds + L_XCF))[(16 * w + r) * 64 + lane] = xcv[r]; ((LAS bf16*)(lds + L_XCB))[(16 * w + r) * 72 + lane] = (bf16)f2bf(xcv[r]); }
        }
        LDS_WAIT();
        float hl[4][4], pl[4][4];
        {
            bf16x8 af[2];
#pragma unroll
            for (int s = 0; s < 2; ++s) af[s] = *(const LAS bf16x8*)(lds + L_XCB + ((16 * w + col) * 72 + 32 * s + 8 * q) * 2);
            float xc[4][4];
#pragma unroll
            for (int ob = 0; ob < 4; ++ob)
#pragma unroll
                for (int r = 0; r < 4; ++r) xc[ob][r] = ((const LAS float*)(lds + L_XCF))[(16 * w + 4 * q + r) * 64 + 16 * ob + col];
#pragma unroll
            for (int ob = 0; ob < 4; ++ob) {
                f32x4 za = (f32x4){ba[ob], ba[ob], ba[ob], ba[ob]}, zx = (f32x4){bx[ob], bx[ob], bx[ob], bx[ob]};
#pragma unroll
                for (int s = 0; s < 2; ++s) { za = __builtin_amdgcn_mfma_f32_16x16x32_bf16(af[s], wfa[ob][s], za, 0, 0, 0); zx = __builtin_amdgcn_mfma_f32_16x16x32_bf16(af[s], wfx[ob][s], zx, 0, 0, 0); }
                float hrun = 0.f, prun = 1.f;
#pragma unroll
                for (int hh = 0; hh < 2; ++hh) {
                    typedef float f32x2 __attribute__((ext_vector_type(2)));
                    const f32x2 one = (f32x2){1.0f, 1.0f};
                    const f32x2 da = (f32x2){__builtin_amdgcn_exp2f(za[2 * hh]), __builtin_amdgcn_exp2f(za[2 * hh + 1])} + one, dx = (f32x2){__builtin_amdgcn_exp2f(zx[2 * hh]), __builtin_amdgcn_exp2f(zx[2 * hh + 1])} + one;
                    const f32x2 ra = (f32x2){__builtin_amdgcn_rcpf(da.x), __builtin_amdgcn_rcpf(da.y)}, ri = (f32x2){__builtin_amdgcn_rcpf(dx.x), __builtin_amdgcn_rcpf(dx.y)};
                    const f32x2 yy = ra * cl[ob];
                    const f32x2 av = (f32x2){__builtin_amdgcn_exp2f(yy.x), __builtin_amdgcn_exp2f(yy.y)};
                    const f32x2 om = __builtin_elementwise_fma(-av, av, one);
                    const f32x2 uu = (f32x2){__builtin_amdgcn_sqrtf(om.x), __builtin_amdgcn_sqrtf(om.y)} * ri * (f32x2){xc[ob][2 * hh], xc[ob][2 * hh + 1]};
                    hrun = av.x * hrun + uu.x; prun = prun * av.x; hl[ob][2 * hh] = hrun; pl[ob][2 * hh] = prun;
                    hrun = av.y * hrun + uu.y; prun = prun * av.y; hl[ob][2 * hh + 1] = hrun; pl[ob][2 * hh + 1] = prun;
                }
            }
        }
        float pe[4], he[4];
        {
            float pg[4][4], hg[4][4];
#pragma unroll
            for (int ob = 0; ob < 4; ++ob)
#pragma unroll
                for (int g = 0; g < 4; ++g) { int ad = (col + 16 * g) << 2; asm volatile("" : "+v"(ad));
                                              pg[ob][g] = __builtin_bit_cast(float, __builtin_amdgcn_ds_bpermute(ad, __builtin_bit_cast(int, pl[ob][3])));
                                              hg[ob][g] = __builtin_bit_cast(float, __builtin_amdgcn_ds_bpermute(ad, __builtin_bit_cast(int, hl[ob][3]))); }
            LDS_WAIT();
#pragma unroll
            for (int ob = 0; ob < 4; ++ob) {
                float pacc = 1.f, hacc = 0.f; pe[ob] = 1.f; he[ob] = 0.f;
#pragma unroll
                for (int g = 0; g < 4; ++g) { if (g == q) { pe[ob] = pacc; he[ob] = hacc; } hacc = pg[ob][g] * hacc + hg[ob][g]; pacc = pacc * pg[ob][g]; }
                if (q == 0) { v2u cw2; cw2.x = __builtin_bit_cast(unsigned, pacc); cw2.y = __builtin_bit_cast(unsigned, hacc); *(LAS v2u*)(lds + L_CAR + (w * 64 + 16 * ob + col) * 8) = cw2; }
            }
        }
        LDS_BARRIER();
        {
            unsigned short gv[4][4];
#pragma unroll
            for (int ob = 0; ob < 4; ++ob)
#pragma unroll
                for (int r = 0; r < 4; ++r) gv[ob][r] = ((const LAS bf16*)gt)[(16 * w + 4 * q + r) * 64 + 16 * ob + col];
            v2u cr[8];
#pragma unroll
            for (int w2 = 0; w2 < 8; ++w2) cr[w2] = *(const LAS v2u*)(lds + L_CAR + (w2 * 64 + 16 * q + col) * 8);
            float hinq = hcar, hall = hcar;
#pragma unroll
            for (int w2 = 0; w2 < 8; ++w2) { const unsigned ppu = cr[w2].x, hhu = cr[w2].y; const float pp = __uint_as_float(ppu), hh = __uint_as_float(hhu);
                hall = pp * hall + hh; if (w2 < w) hinq = pp * hinq + hh; }
            hcar = hall;
#pragma unroll
            for (int ob = 0; ob < 4; ++ob) {
                const float hin = __builtin_bit_cast(float, __builtin_amdgcn_ds_bpermute((col + 16 * ob) << 2, __builtin_bit_cast(int, hinq)));
                const float cin = he[ob] + pe[ob] * hin;
#pragma unroll
                for (int r = 0; r < 4; ++r) { const float h = hl[ob][r] + pl[ob][r] * cin;
                    LAS bf16* gp = (LAS bf16*)gt + (16 * w + 4 * q + r) * 64 + 16 * ob + col; *gp = (bf16)f2bf(h * bf2f(gv[ob][r]));
                }
            }
        }
    }
    {
        const int tid = F.tid_();
        LDS_BARRIER();
#pragma unroll
        for (int r = 0; r < 2; ++r) { const int p = tid + 512 * r, row = p >> 3, seg = p & 7;
            *(v4u*)(Y + (size_t)(b * SEQ + SEQ - 128 + row) * DM + j * RB + 8 * seg) = *(const LAS v4u*)(lds + L_AA + 16384 * ((SEQ / 128 - 1) & 1) + row * 128 + seg * 16); }
    }
}

constexpr int RS = 136;
constexpr int R_KI = 0, R_KT = 34816, R_VT = 69632, R_PT = 104448, R_END = 139264;
static_assert(R_END <= MISC_OFF, "retention lds");
typedef short s16x4 __attribute__((ext_vector_type(4)));
constexpr int RS2 = 144;
constexpr int R2_KI = 0, R2_VI = 36864, R2_PT = 73728, R2_END = 110592;
static_assert(R2_END <= MISC_OFF, "retention v2 lds");
__device__ __forceinline__ bf16x8 tr_pair(LAS unsigned char* p0, LAS unsigned char* p1) {
    const s16x4 lo = __builtin_amdgcn_ds_read_tr16_b64_v4i16((LAS s16x4*)p0), hi = __builtin_amdgcn_ds_read_tr16_b64_v4i16((LAS s16x4*)p1);
    return __builtin_shufflevector(lo, hi, 0, 1, 2, 3, 4, 5, 6, 7);
}
__device__ __forceinline__ void ret_unit3(const Frame& F, const Args& a, int b, int hh) {
    LAS unsigned char* lds = F.lds;
    const bf16* Qg = (const bf16*)(KA::ws() + WS_PH) + 2 * PREG + (size_t)(b * NHEAD + hh) * SEQ * 128;
    const bf16* Kg = Qg + PREG; const bf16* Vg = Kg + PREG; const bf16* Gg = Vg + PREG;
    constexpr size_t HB = (size_t)SEQ * 32;
    bf16* Y = (bf16*)(KA::ws() + WS_Y);
    const float gamma = 1.0f - __builtin_amdgcn_exp2f(-5.0f - (float)hh); const float lg = __builtin_amdgcn_logf(gamma);
    const float cdecay = __builtin_amdgcn_exp2f(128.0f * lg);
    f32x4 kvacc[8];
#pragma unroll
    for (int d = 0; d < 8; ++d) kvacc[d] = (f32x4){0.f, 0.f, 0.f, 0.f};
    v4u pk_[4], pv_[4]; bf16x8 qn[4];
    {
        const int tid = F.tid_(), lane = tid & 63, col = lane & 15, q = lane >> 4; const size_t row0 = 0;
#pragma unroll
        for (int i = 0; i < 4; ++i) { const int m = tid >> 2, q4 = tid & 3;
            pk_[i] = *(const v4u*)(Kg + (size_t)i * HB + (row0 + m) * 32 + 8 * q4); pv_[i] = *(const v4u*)(Vg + (size_t)i * HB + (row0 + m) * 32 + 8 * q4); }
#pragma unroll
        for (int s = 0; s < 4; ++s) qn[s] = *(const bf16x8*)(Qg + (size_t)s * HB + (row0 + 16 * F.wave + col) * 32 + 8 * q);
    }
    for (int n = 0; n < NCHUNK; ++n) {
        int tid = F.tid_(), w = F.wave; asm volatile("" : "+v"(tid)); asm volatile("" : "+s"(w));
        const int lane = tid & 63, col = lane & 15, q = lane >> 4;
        const size_t row0 = (size_t)b * SEQ + (size_t)n * CHUNK, tok0 = (size_t)n * CHUNK;
        LDS_BARRIER();
#pragma unroll
        for (int i = 0; i < 4; ++i) { const int m = tid >> 2, d8 = 4 * i + (tid & 3);
            *(LAS v4u*)(lds + R2_KI + (m * RS2 + 8 * d8) * 2) = pk_[i]; *(LAS v4u*)(lds + R2_VI + (m * RS2 + 8 * d8) * 2) = pv_[i]; }
#pragma unroll
        for (int db = 0; db < 8; ++db) { v2u pw; pw.x = pk2(kvacc[db][0], kvacc[db][1]); pw.y = pk2(kvacc[db][2], kvacc[db][3]);
            *(LAS v2u*)(lds + R2_PT + ((16 * w + col) * RS2 + 16 * db + 4 * q) * 2) = pw; }
        bf16x8 qf[4];
#pragma unroll
        for (int s = 0; s < 4; ++s) qf[s] = qn[s];
        LDS_BARRIER();
        if (n + 1 < NCHUNK) {
            const size_t rown = tok0 + CHUNK;
#pragma unroll
            for (int i = 0; i < 4; ++i) { const int m = tid >> 2, q4 = tid & 3;
                pk_[i] = *(const v4u*)(Kg + (size_t)i * HB + (rown + m) * 32 + 8 * q4); pv_[i] = *(const v4u*)(Vg + (size_t)i * HB + (rown + m) * 32 + 8 * q4); }
#pragma unroll
            for (int s = 0; s < 4; ++s) qn[s] = *(const bf16x8*)(Qg + (size_t)s * HB + (rown + 16 * w + col) * 32 + 8 * q);
        }
        v2u gpre[8];
#pragma unroll
        for (int eb = 0; eb < 8; ++eb) gpre[eb] = *(const v2u*)(Gg + (size_t)(eb >> 1) * HB + (tok0 + 16 * w + col) * 32 + 16 * (eb & 1) + 4 * q);
#define SCHED_FENCE() __builtin_amdgcn_sched_barrier(0)
        f32x4 out[8];
        {
            bf16x8 pf[2][8];
#pragma unroll
            for (int eb = 0; eb < 8; ++eb) { out[eb] = (f32x4){0.f, 0.f, 0.f, 0.f}; pf[0][eb] = *(const LAS bf16x8*)(lds + R2_PT + ((16 * eb + col) * RS2 + 8 * q) * 2); }
#pragma unroll
            for (int s = 0; s < 4; ++s) {
                if (s < 3) {
#pragma unroll
                    for (int eb = 0; eb < 8; ++eb) pf[(s + 1) & 1][eb] = *(const LAS bf16x8*)(lds + R2_PT + ((16 * eb + col) * RS2 + 32 * (s + 1) + 8 * q) * 2);
                }
                SCHED_FENCE();
#pragma unroll
                for (int eb = 0; eb < 8; ++eb) out[eb] = __builtin_amdgcn_mfma_f32_16x16x32_bf16(pf[s & 1][eb], qf[s], out[eb], 0, 0, 0);
                SCHED_FENCE();
            }
#pragma unroll
            for (int eb = 0; eb < 8; ++eb) out[eb] = out[eb] * cdecay;
        }
        LAS unsigned char* trV = lds + R2_VI + ((col >> 2) * RS2 + 4 * (col & 3)) * 2;
        LAS unsigned char* trK = lds + R2_KI + ((col >> 2) * RS2 + 4 * (col & 3)) * 2;
#pragma unroll
        for (int t = 0; t < 4; ++t) {
            if (2 * t <= w) {
                bf16x8 ka[4], kb[4], vf[8];
#pragma unroll
                for (int s = 0; s < 4; ++s) { ka[s] = *(const LAS bf16x8*)(lds + R2_KI + ((32 * t + col) * RS2 + 32 * s + 8 * q) * 2);
                                              kb[s] = *(const LAS bf16x8*)(lds + R2_KI + ((32 * t + 16 + col) * RS2 + 32 * s + 8 * q) * 2); }
#pragma unroll
                for (int eb = 0; eb < 8; ++eb) vf[eb] = tr_pair(trV + ((32 * t + 4 * q) * RS2 + 16 * eb) * 2, trV + ((32 * t + 16 + 4 * q) * RS2 + 16 * eb) * 2);
                SCHED_FENCE();
                f32x4 sa = (f32x4){0.f, 0.f, 0.f, 0.f}, sb = (f32x4){0.f, 0.f, 0.f, 0.f};
#pragma unroll
                for (int s = 0; s < 4; ++s) { sa = __builtin_amdgcn_mfma_f32_16x16x32_bf16(ka[s], qf[s], sa, 0, 0, 0); sb = __builtin_amdgcn_mfma_f32_16x16x32_bf16(kb[s], qf[s], sb, 0, 0, 0); }
                const int c = 16 * w + col;
                float va[4], vb[4];
#pragma unroll
                for (int r = 0; r < 4; ++r) { const int ma = 32 * t + 4 * q + r, mb = ma + 16;
                    va[r] = (c >= ma) ? sa[r] : 0.f; vb[r] = (c >= mb) ? sb[r] : 0.f; }
                v4u sw; sw.x = pk2(va[0], va[1]); sw.y = pk2(va[2], va[3]); sw.z = pk2(vb[0], vb[1]); sw.w = pk2(vb[2], vb[3]);
                const bf16x8 sfr = __builtin_bit_cast(bf16x8, sw);
                SCHED_FENCE();
#pragma unroll
                for (int eb = 0; eb < 8; ++eb) out[eb] = __builtin_amdgcn_mfma_f32_16x16x32_bf16(vf[eb], sfr, out[eb], 0, 0, 0);
                SCHED_FENCE();
            }
        }
        {
            float sq = 0.f;
#pragma unroll
            for (int eb = 0; eb < 8; ++eb) sq += (out[eb][0] * out[eb][0] + out[eb][1] * out[eb][1]) + (out[eb][2] * out[eb][2] + out[eb][3] * out[eb][3]);
            sq += shx(sq, 16, lane); sq += shx(sq, 32, lane);
            const float rs = rsqrtf(sq * (1.0f / DH) + EPS);
            const size_t row = row0 + 16 * w + col;
#pragma unroll
            for (int eb = 0; eb < 8; ++eb) {
                const v2u gw2 = gpre[eb];
                v2u o; o.x = pk2(out[eb][0] * rs * bflo(gw2.x), out[eb][1] * rs * bfhi(gw2.x)); o.y = pk2(out[eb][2] * rs * bflo(gw2.y), out[eb][3] * rs * bfhi(gw2.y));
                *(v2u*)(Y + row * DM + DRNN + 128 * hh + 16 * eb + 4 * q) = o;
            }
        }
        {
            bf16x8 vfz[4];
#pragma unroll
            for (int t = 0; t < 4; ++t) vfz[t] = tr_pair(trV + ((32 * t + 8 * q) * RS2 + 16 * w) * 2, trV + ((32 * t + 8 * q + 4) * RS2 + 16 * w) * 2);
#pragma unroll
            for (int dp = 0; dp < 4; ++dp) {
                bf16x8 kf[2][4];
#pragma unroll
                for (int h2 = 0; h2 < 2; ++h2)
#pragma unroll
                    for (int t = 0; t < 4; ++t) kf[h2][t] = tr_pair(trK + ((32 * t + 8 * q) * RS2 + 16 * (2 * dp + h2)) * 2, trK + ((32 * t + 8 * q + 4) * RS2 + 16 * (2 * dp + h2)) * 2);
                SCHED_FENCE();
                f32x4 c0 = kvacc[2 * dp] * cdecay, c1 = kvacc[2 * dp + 1] * cdecay;
#pragma unroll
                for (int t = 0; t < 4; ++t) { c0 = __builtin_amdgcn_mfma_f32_16x16x32_bf16(kf[0][t], vfz[t], c0, 0, 0, 0); c1 = __builtin_amdgcn_mfma_f32_16x16x32_bf16(kf[1][t], vfz[t], c1, 0, 0, 0); }
                kvacc[2 * dp] = c0; kvacc[2 * dp + 1] = c1;
                SCHED_FENCE();
            }
        }
    }
}

__global__ void __launch_bounds__(NWAVES * 64, 2) hymba_fwd(Args args) {
    extern __shared__ __attribute__((aligned(16))) unsigned char lds_raw[];
    Frame F;
    F.lds = (LAS unsigned char*)lds_raw;
    F.wave = __builtin_amdgcn_readfirstlane((int)threadIdx.x >> 6); F.G = gridDim.x;
    unsigned char* ws = KA::ws();
    const int lo = KA::lo(), hi = KA::hi();
    if (F.tid_() < 16) ((LAS unsigned*)(F.lds + MISC_OFF))[F.tid_()] = 0u;
#if PROBE_TMASK
    __syncthreads(); if (F.tid_() == 0) { volatile LAS unsigned long long* tm = (volatile LAS unsigned long long*)(F.lds + MISC_OFF + 16); tm[0] = __builtin_amdgcn_s_memrealtime(); tm[1] = 0ull; }
#endif
    __syncthreads();
    XcdBarrier bar; bar.bar = (unsigned*)(ws + WS_CTL) + CW_BAR; bar.x = 0; bar.st = nullptr; bar.wave0 = false;
    if (hi - lo > 1) bar = xcd_barrier_post((unsigned*)(ws + WS_CTL) + CW_BAR, (volatile LAS unsigned*)(F.lds + MISC_OFF), F.wave);
#define IN(k) (lo <= (k) && (k) < hi)
#if PROBE_TMASK
#define SEAM(k) do { if (blockIdx.x == 0 && F.tid_() == 0) { volatile LAS unsigned long long* tm = (volatile LAS unsigned long long*)(F.lds + MISC_OFF + 16); const unsigned long long tn = __builtin_amdgcn_s_memrealtime(); \
        if ((PROBE_TMASK >> (k)) & 1) tm[1] += tn - tm[0]; tm[0] = tn; \
        if ((k) == 7 * DEPTH) __hip_atomic_store((unsigned*)(ws + WS_CTL) + 64, (unsigned)tm[1], __ATOMIC_RELAXED, __HIP_MEMORY_SCOPE_AGENT); } \
    if (IN(k) && IN((k) + 1)) xcd_barrier(bar); } while (0)
#else
#define SEAM(k) do { if (IN(k) && IN((k) + 1)) xcd_barrier(bar); } while (0)
#endif

    bf16* XB = (bf16*)(ws + WS_XB); float* SS = (float*)(ws + WS_SS); bf16* YB = (bf16*)(ws + WS_Y); bf16* PH = (bf16*)(ws + WS_PH);

#ifndef SK_PREP
    if (IN(0)) { phase_prep(F, args); }
#endif

    SEAM(0);
    for (int sb = 0; sb < 3 * DEPTH; ++sb) {
        const int l = sb / 3, t = sb % 3; const int p0 = 1 + 7 * l + (t == 0 ? 0 : (t == 1 ? 2 : 5));
        unsigned char* wl = ws + WS_W + (size_t)l * SZ_WLAYER;
        if (t != 1) {
#ifndef SK_FFNIN
            if (IN(p0)) {
                const int mrows = KA::mlim() ? KA::mlim() : MTOK;
                pg8::Gemm g{XB, (const bf16*)(wl + (t == 0 ? OFF_W1IN : OFF_W2IN)), mrows, NFF, DM}; pg8::StaticOrder S; S.init(mrows, NFF, F.G, (int)blockIdx.x);
                EpiSwiGLU E{PH, SS, F.lds, {}};
                pg8::gemm_phase<EpiSwiGLU, pg8::StaticOrder, PG8_ALIGN, PG8_SP2, true>(F.lds, g, S, E, F.wave);
            }
#endif

            SEAM(p0);
#ifndef SK_FFNOUT
            if (IN(p0 + 1)) {
                pg8::Gemm g{PH, (const bf16*)(wl + (t == 0 ? OFF_W1OUT : OFF_W2OUT)), MTOK, DM, DFF}; pg8::StaticOrder S; S.init(MTOK, DM, F.G, (int)blockIdx.x, FFNOUT_REV);
                EpiResid E{XB, SS, KA::dry() ? 0.f : 0.5f};
                pg8::gemm_phase<EpiResid, pg8::StaticOrder, PG8_ALIGN, PG8_SP2, true, true>(F.lds, g, S, E, F.wave);
            }
#endif

            SEAM(p0 + 1);
        } else {
#ifndef SK_PROJ
            if (IN(p0)) {
                pg8::Gemm g{XB, (const bf16*)(wl + OFF_WIN), MTOK, DIN, DM}; pg8::StaticOrder S; S.init(MTOK, DIN, F.G, (int)blockIdx.x);
                EpiProj E{PH, SS, (const int*)KA::in(1), F.lds, {}};
                pg8::gemm_phase<EpiProj, pg8::StaticOrder, PG8_ALIGN, PG8_SP2, true>(F.lds, g, S, E, F.wave);
            }
#endif

            SEAM(p0);
            if (IN(p0 + 1)) {
                int r0 = blockIdx.x, r1 = BATCH * NHEAD, rs = F.G, l0 = blockIdx.x, l1 = BATCH * NRB, ls = F.G;
                if (F.G == 256) { const int role = (blockIdx.x >> 3) & 1, idx = ((blockIdx.x >> 4) << 3) + (blockIdx.x & 7);
                    if (role == 0) { r0 = idx; r1 = idx + 1; l0 = l1 = 0; } else { r0 = r1 = 0; l0 = 2 * idx; l1 = 2 * idx + 2; ls = 1; } }
#ifndef SK_LRU
                for (int rep = 0; rep < REP_LRU; ++rep)
                for (int u = l0; u < l1; u += ls) lru_unit3(F, args, l, u / NRB, u % NRB);
#endif
#ifndef SK_RET
                for (int rep = 0; rep < REP_RET; ++rep)
                for (int u = r0; u < r1; u += rs) ret_unit3(F, args, u / NHEAD, u % NHEAD);
#endif
            }
            SEAM(p0 + 1);
#ifndef SK_WOUT
            if (IN(p0 + 2)) {
                pg8::Gemm g{YB, (const bf16*)(wl + OFF_WOUT), MTOK, DM, DM}; pg8::StaticOrder S; S.init(MTOK, DM, F.G, (int)blockIdx.x);
                EpiResid E{XB, SS, KA::dry() ? 0.f : 1.0f};
                pg8::gemm_phase<EpiResid, pg8::StaticOrder, PG8_ALIGN, PG8_SP2>(F.lds, g, S, E, F.wave);
            }
#endif

            SEAM(p0 + 2);
        }
    }
#ifndef SK_FINAL
    if (IN(1 + 7 * DEPTH)) phase_final(F, args);
#endif

#undef IN
#undef SEAM
}

extern "C" void kernel_launch(void* const* d_in, const int* in_sizes, int n_in, void* d_out, int out_size, void* d_ws, size_t ws_size, hipStream_t stream) {
    static int grid = 0;
    if (grid == 0) {
        if (n_in != 19 || in_sizes[0] != MTOK * DM || out_size != MTOK * DM || ws_size < WS_END) {
            fprintf(stderr, "kernel_launch: unexpected shapes (n_in %d, in0 %d, out %d, ws %zu); nothing launched\n", n_in, n_in > 0 ? in_sizes[0] : -1, out_size, ws_size); grid = -1; return; }
        int dev = 0, cus = 0, per_cu = 0;
        if (hipGetDevice(&dev) != hipSuccess || hipDeviceGetAttribute(&cus, hipDeviceAttributeMultiprocessorCount, dev) != hipSuccess) { grid = -1; return; }
        if (hipFuncSetAttribute((const void*)hymba_fwd, hipFuncAttributeMaxDynamicSharedMemorySize, LDS_BYTES) != hipSuccess) { fprintf(stderr, "kernel_launch: hipFuncSetAttribute failed\n"); grid = -1; return; }
        if (hipOccupancyMaxActiveBlocksPerMultiprocessor(&per_cu, (const void*)hymba_fwd, NWAVES * 64, LDS_BYTES) != hipSuccess || per_cu < 1)
            fprintf(stderr, "kernel_launch: note: occupancy query reports %d workgroups per CU\n", per_cu);
        (void)hipGetLastError();
        grid = cus;
    }
    if (grid < 0) return;
    (void)hipMemsetAsync((char*)d_ws + WS_CTL, 0, CTL_ZERO_BYTES, stream);
    Args a{};
    for (int i = 0; i < 19; ++i) a.in[i] = d_in[i];
    a.out = (float*)d_out; a.ws = (unsigned char*)d_ws;
    constexpr int NPH = 2 + 7 * DEPTH;
#if PROBE_REP_PHASE >= 200
    for (int p = 0; p < NPH; ++p) { a.ph_lo = p; a.ph_hi = p + 1; a.mlim = 0; hipLaunchKernelGGL(hymba_fwd, dim3(grid), dim3(NWAVES * 64), LDS_BYTES, stream, a);
        if (p == 1) for (int rep = 0; rep < 4; ++rep) { a.mlim = (PROBE_REP_PHASE - 200) * 256; hipLaunchKernelGGL(hymba_fwd, dim3(grid), dim3(NWAVES * 64), LDS_BYTES, stream, a); } }
#elif PROBE_REP_PHASE >= 0
    for (int p = 0; p < NPH; ++p) for (int rep = 0; rep < ((p == PROBE_REP_PHASE || PROBE_REP_PHASE == 99) ? 2 : 1); ++rep) { a.ph_lo = p; a.ph_hi = p + 1; a.dry = ((p == PROBE_REP_PHASE || PROBE_REP_PHASE == 99) && rep == 0) ? 1 : 0; hipLaunchKernelGGL(hymba_fwd, dim3(grid), dim3(NWAVES * 64), LDS_BYTES, stream, a); }
#elif MK_PER_PHASE
    for (int p = 0; p < NPH; ++p) { a.ph_lo = p; a.ph_hi = p + 1; hipLaunchKernelGGL(hymba_fwd, dim3(grid), dim3(NWAVES * 64), LDS_BYTES, stream, a); }
#else
    a.ph_lo = 0; a.ph_hi = NPH; hipLaunchKernelGGL(hymba_fwd, dim3(grid), dim3(NWAVES * 64), LDS_BYTES, stream, a);
#endif
}
```
